# Optimizing an MI355X kernel written in HIP

```python
import math
import jax, jax.numpy as jnp
from jax import lax
import numpy as np

D_MODEL = 1024
BATCH = 2
SEQ = 8192
DEPTH = 1
DEC_BATCH = 128
DEC_SEQ = 4
PAST_LEN = 2048
PAGE_SIZE = 128

MIX_WIDTH = D_MODEL
ATTN_WIDTH = MIX_WIDTH // 2
REC_WIDTH = MIX_WIDTH - ATTN_WIDTH
A_HEADS = 4
A_HD = ATTN_WIDTH // (2 * A_HEADS)
A_VD = 2 * A_HD
R_HEADS = 4
R_DK = REC_WIDTH // R_HEADS
R_DV = REC_WIDTH // R_HEADS
REC_CHUNK = 64
N_BUCKETS = 32
MAX_DISTANCE = 128
D_FF = ((8 * D_MODEL // 3 + 127) // 128) * 128
CONV_W = 3
Q_BLOCK = 128
EPS = 1e-6
IN_COLS = 3 * ATTN_WIDTH + 4 * REC_WIDTH
SPLITS = [ATTN_WIDTH, 2 * ATTN_WIDTH, 3 * ATTN_WIDTH,
          3 * ATTN_WIDTH + REC_WIDTH, 3 * ATTN_WIDTH + 2 * REC_WIDTH, 3 * ATTN_WIDTH + 3 * REC_WIDTH]

kernel_name = 'hymba_diffattn_hgrn2_convglu_step'


def rms_norm(x, g):
    xf = x.astype(jnp.float32)
    y = xf * lax.rsqrt(jnp.mean(xf * xf, axis=-1, keepdims=True) + EPS)
    return (y * g.astype(jnp.float32)).astype(x.dtype)


def rel_bucket(q_pos, k_pos):
    n = jnp.maximum(q_pos[:, None] - k_pos[None, :], 0)
    max_exact = N_BUCKETS // 2
    nf = jnp.maximum(n, 1).astype(jnp.float32)
    large = max_exact + (jnp.log(nf / max_exact) / math.log(MAX_DISTANCE / max_exact)
                         * (N_BUCKETS - max_exact)).astype(jnp.int32)
    large = jnp.minimum(large, N_BUCKETS - 1)
    return jnp.where(n < max_exact, n, large)


def diff_attn_block(q, k, v, q_pos, k_pos, rel_bias, lam):
    s = jnp.einsum('bqhmd,bkhmd->bhmqk', q, k).astype(jnp.float32) * (A_HD ** -0.5)
    bias = jnp.transpose(rel_bias.astype(jnp.float32)[rel_bucket(q_pos, k_pos)], (2, 0, 1))
    mask = k_pos[None, :] <= q_pos[:, None]
    s = jnp.where(mask, s + bias[None, :, None], -jnp.inf)
    p = jax.nn.softmax(s, axis=-1)
    a = p[:, :, 0] - lam * p[:, :, 1]
    return jnp.einsum('bhqk,bkhv->bqhv', a.astype(v.dtype), v)


def attn_prompt(q, k, v, rel_bias, lam):
    B, T = q.shape[0], q.shape[1]
    nqb = T // Q_BLOCK
    pos = jnp.arange(T, dtype=jnp.int32)
    qb = jnp.moveaxis(q.reshape(B, nqb, Q_BLOCK, A_HEADS, 2, A_HD), 1, 0)
    pb = pos.reshape(nqb, Q_BLOCK)
    ob = lax.map(lambda a: diff_attn_block(a[0], k, v, a[1], pos, rel_bias, lam), (qb, pb))
    return jnp.moveaxis(ob, 0, 1).reshape(B, T, A_HEADS, A_VD)


def hgrn_chunk(S, q, logf, kk, v):
    L = q.shape[2]
    b = jnp.cumsum(logf, axis=2)
    causal = jnp.tril(jnp.ones((L, L), dtype=bool))
    diff = b[:, :, :, None, :] - b[:, :, None, :, :]
    dec = jnp.exp(jnp.where(causal[None, None, :, :, None], diff, -jnp.inf))
    A = jnp.einsum('bhtk,bhsk,bhtsk->bhts', q, kk, dec)
    o = jnp.einsum('bhts,bhsv->bhtv', A, v) + jnp.einsum('bhtk,bhkv->bhtv', q * jnp.exp(b), S)
    b_last = b[:, :, -1:, :]
    S_new = jnp.exp(b_last[:, :, 0, :])[..., None] * S + jnp.einsum('bhsk,bhsv->bhkv', kk * jnp.exp(b_last - b), v)
    return S_new, o


def hgrn_mixer(rq, rf, ri, rg, S0, lb, g_norm, chunk):
    B, T = rq.shape[0], rq.shape[1]
    f = lb + (1.0 - lb) * jax.nn.sigmoid(rf.astype(jnp.float32))
    logf = jnp.log(f)
    kk = 1.0 - f
    heads = lambda t: t.astype(jnp.float32).reshape(B, T, R_HEADS, -1).transpose(0, 2, 1, 3)
    nC = T // chunk
    to_chunks = lambda t: jnp.moveaxis(t.reshape(B, R_HEADS, nC, chunk, t.shape[-1]), 2, 0)
    xs = (to_chunks(heads(rq)), to_chunks(heads(logf)), to_chunks(heads(kk)), to_chunks(heads(ri)))
    S_fin, o = lax.scan(lambda S, a: hgrn_chunk(S, *a), S0.astype(jnp.float32), xs)
    o = jnp.moveaxis(o, 0, 2).reshape(B, R_HEADS, T, R_DV).transpose(0, 2, 1, 3)
    o = rms_norm(o, g_norm) * jax.nn.silu(rg.astype(jnp.float32).reshape(B, T, R_HEADS, R_DV))
    return o.reshape(B, T, REC_WIDTH).astype(rq.dtype), S_fin.astype(S0.dtype)


def project(h, w, qk_g):
    B, T = h.shape[0], h.shape[1]
    z = h @ w
    aq, ak, av, rq, rf, ri, rg = jnp.split(z, SPLITS, axis=-1)
    aq = rms_norm(aq.reshape(B, T, A_HEADS, 2, A_HD), qk_g[0])
    ak = rms_norm(ak.reshape(B, T, A_HEADS, 2, A_HD), qk_g[1])
    av = av.reshape(B, T, A_HEADS, A_VD)
    return aq, ak, av, rq, rf, ri, rg


def mixer_out(o_attn, o_rec, subln, lam_init, w_out):
    B, T = o_attn.shape[0], o_attn.shape[1]
    oa = (rms_norm(o_attn, subln) * (1.0 - lam_init)).reshape(B, T, ATTN_WIDTH)
    return jnp.concatenate([oa, o_rec.astype(oa.dtype)], axis=-1) @ w_out


def conv_ffn(h, buf, w_gate, w_up, conv_w, conv_b, w_down):
    T = h.shape[1]
    a = h @ w_gate
    ext = jnp.concatenate([buf.astype(a.dtype), a], axis=1)
    c = conv_b + sum(conv_w[j] * ext[:, j:j + T] for j in range(CONV_W))
    y = (jax.nn.silu(c) * (h @ w_up)) @ w_down
    return y, ext[:, -(CONV_W - 1):]


def setup_inputs(seed: int = 0) -> dict:
    key = jax.random.key(seed)
    ks = jax.random.split(key, 24)
    n_pages = PAST_LEN // PAGE_SIZE
    used = DEC_BATCH * n_pages
    n_phys = used + max(1, used // 4)
    nrm = lambda k, s, sc: jax.random.normal(k, s, jnp.float32) * sc
    page_table = jax.random.permutation(ks[0], n_phys)[:used].reshape(DEC_BATCH, n_pages).astype(jnp.int32)
    return {
        'x_prompt': nrm(ks[1], (BATCH, SEQ, D_MODEL), 1.0),
        'x_sample': nrm(ks[2], (DEC_BATCH, DEC_SEQ, D_MODEL), 1.0),
        'cache_k': nrm(ks[3], (DEPTH, n_phys, PAGE_SIZE, A_HEADS, 2, A_HD), 1.0),
        'cache_v': nrm(ks[4], (DEPTH, n_phys, PAGE_SIZE, A_HEADS, A_VD), 1.0),
        'page_table': page_table,
        'state_hgrn': nrm(ks[5], (DEPTH, DEC_BATCH, R_HEADS, R_DK, R_DV), 0.3),
        'state_conv': nrm(ks[6], (DEPTH, DEC_BATCH, CONV_W - 1, D_FF), 1.0),
        'rel_bias': nrm(ks[7], (N_BUCKETS, A_HEADS), 0.5),
        'norm1_g': 1.0 + nrm(ks[8], (DEPTH, D_MODEL), 0.02),
        'w_in': nrm(ks[9], (DEPTH, D_MODEL, IN_COLS), D_MODEL ** -0.5),
        'qk_norm_g': 1.0 + nrm(ks[10], (DEPTH, 2, 2, A_HD), 0.02),
        'lambda_qk': nrm(ks[11], (DEPTH, 4, A_HD), 0.1),
        'subln_g': 1.0 + nrm(ks[12], (DEPTH, A_VD), 0.02),
        'hgrn_lb': nrm(ks[13], (DEPTH + 1, REC_WIDTH), 0.1),
        'hgrn_onorm_g': 1.0 + nrm(ks[14], (DEPTH, R_DV), 0.02),
        'w_out': nrm(ks[15], (DEPTH, MIX_WIDTH, D_MODEL), MIX_WIDTH ** -0.5),
        'norm2_g': 1.0 + nrm(ks[16], (DEPTH, D_MODEL), 0.02),
        'w_gate': nrm(ks[17], (DEPTH, D_MODEL, D_FF), D_MODEL ** -0.5),
        'w_up': nrm(ks[18], (DEPTH, D_MODEL, D_FF), D_MODEL ** -0.5),
        'conv_w': nrm(ks[19], (DEPTH, CONV_W, D_FF), CONV_W ** -0.5),
        'conv_b': nrm(ks[20], (DEPTH, D_FF), 0.01),
        'w_down': nrm(ks[21], (DEPTH, D_FF, D_MODEL), D_FF ** -0.5),
    }


def reference(x_prompt, x_sample, cache_k, cache_v, page_table, state_hgrn, state_conv, rel_bias,
              norm1_g, w_in, qk_norm_g, lambda_qk, subln_g, hgrn_lb, hgrn_onorm_g, w_out,
              norm2_g, w_gate, w_up, conv_w, conv_b, w_down):
    xp, xs = x_prompt, x_sample
    Bp, Tp = xp.shape[0], xp.shape[1]
    Bs, Ts = xs.shape[0], xs.shape[1]
    past_len = page_table.shape[1] * cache_k.shape[2]
    lb_all = jnp.cumsum(jax.nn.softmax(hgrn_lb.astype(jnp.float32), axis=0), axis=0)
    kp_l, vp_l, hp_l, cp_l, ks_l, vs_l, hs_l, cs_l = [], [], [], [], [], [], [], []
    for l in range(DEPTH):
        lam_init = 0.8 - 0.6 * math.exp(-0.3 * l)
        lp = lambda_qk[l].astype(jnp.float32)
        lam = jnp.exp(jnp.sum(lp[0] * lp[1])) - jnp.exp(jnp.sum(lp[2] * lp[3])) + lam_init
        lb = lb_all[l]
        h = rms_norm(xp, norm1_g[l])
        aq, ak, av, rq, rf, ri, rg = project(h, w_in[l], qk_norm_g[l])
        o_att = attn_prompt(aq, ak, av, rel_bias, lam)
        s0 = jnp.zeros((Bp, R_HEADS, R_DK, R_DV), xp.dtype)
        o_rec, S_p = hgrn_mixer(rq, rf, ri, rg, s0, lb, hgrn_onorm_g[l], REC_CHUNK)
        xp = xp + mixer_out(o_att, o_rec, subln_g[l], lam_init, w_out[l])
        buf0 = jnp.zeros((Bp, CONV_W - 1, D_FF), xp.dtype)
        y, cbuf_p = conv_ffn(rms_norm(xp, norm2_g[l]), buf0, w_gate[l], w_up[l], conv_w[l], conv_b[l], w_down[l])
        xp = xp + y
        kp_l.append(ak); vp_l.append(av); hp_l.append(S_p); cp_l.append(cbuf_p)
        h = rms_norm(xs, norm1_g[l])
        aq, ak, av, rq, rf, ri, rg = project(h, w_in[l], qk_norm_g[l])
        past_k = cache_k[l][page_table].reshape(Bs, past_len, A_HEADS, 2, A_HD)
        past_v = cache_v[l][page_table].reshape(Bs, past_len, A_HEADS, A_VD)
        k_all = jnp.concatenate([past_k.astype(ak.dtype), ak], axis=1)
        v_all = jnp.concatenate([past_v.astype(av.dtype), av], axis=1)
        q_pos = past_len + jnp.arange(Ts, dtype=jnp.int32)
        k_pos = jnp.arange(past_len + Ts, dtype=jnp.int32)
        o_att = diff_attn_block(aq, k_all, v_all, q_pos, k_pos, rel_bias, lam)
        o_rec, S_s = hgrn_mixer(rq, rf, ri, rg, state_hgrn[l], lb, hgrn_onorm_g[l], Ts)
        xs = xs + mixer_out(o_att, o_rec, subln_g[l], lam_init, w_out[l])
        y, cbuf_s = conv_ffn(rms_norm(xs, norm2_g[l]), state_conv[l], w_gate[l], w_up[l], conv_w[l], conv_b[l], w_down[l])
        xs = xs + y
        ks_l.append(ak); vs_l.append(av); hs_l.append(S_s); cs_l.append(cbuf_s)
    return (xp, xs, jnp.stack(kp_l), jnp.stack(vp_l), jnp.stack(hp_l), jnp.stack(cp_l),
            jnp.stack(ks_l), jnp.stack(vs_l), jnp.stack(hs_l), jnp.stack(cs_l))
```

```cpp
#include <hip/hip_runtime.h>
#include <hip/hip_bf16.h>
#include <cstdio>
#include <cstdint>
#include <cmath>
namespace pg8 {
#define PG8_LAS __attribute__((address_space(3)))
typedef unsigned short bf16_t;
typedef short bf16x8 __attribute__((ext_vector_type(8)));
typedef float f32x4 __attribute__((ext_vector_type(4)));
typedef unsigned u32x4 __attribute__((ext_vector_type(4)));
constexpr int BM = 256, BK = 64, HALF = 128, HTB = HALF * BK * 2  , STAGE_BYTES = 8 * HTB, NXCD = 8, WGM = 8;

__host__ __device__ __forceinline__ int lds_byte(int r, int c) { const int st = (r >> 4) * 2 + (c >> 5), rr = r & 15, cc = c & 31, ob = rr * 64 + cc * 2; return st * 1024 + (ob ^ (((ob >> 9) & 1) << 5)); }
__host__ __device__ __forceinline__ void stage_rc(int b, int& R, int& C) { const int st = b / 1024, sb = b % 1024, swz = sb ^ (((sb >> 9) & 1) << 5); R = (st >> 1) * 16 + swz / 64; C = (st & 1) * 32 + (swz % 64) / 2; }
__host__ __device__ __forceinline__ int perm32(int rho) { const int n = rho >> 4, i = rho & 15; return 8 * (i >> 2) + 4 * n + (i & 3); }

struct Unit { int pm, pn; };
struct Gemm { const bf16_t* A; const bf16_t* Bt; int M, N, K; };

struct StaticOrder {
    int nM, nN, nwg, G, c;
    __host__ __device__ void init(int M, int N, int G_, int c_) { nM = M / BM; nN = N / BM; nwg = nM * nN; G = G_; c = c_; }
    __host__ __device__ bool next(int i, Unit& u) const {
        const long L = (long)i * G + c; if (L >= nwg) return false;
        int wgid = (int)L; { const int q = nwg / NXCD, r = nwg % NXCD, xcd = wgid % NXCD, off = wgid / NXCD; wgid = (xcd < r ? xcd * (q + 1) : r * (q + 1) + (xcd - r) * q) + off; }
        const int nig = WGM * nN, gid = wgid / nig, fm = gid * WGM, gsz = (nM - fm) < WGM ? (nM - fm) : WGM;
        u.pm = fm + ((wgid % nig) % gsz); u.pn = (wgid % nig) / gsz; return true;
    }
    __device__ __forceinline__ void a_ready(const Unit&) const {}
    __device__ __forceinline__ void done(const Unit&) const {}
};

typedef float f32x2_t __attribute__((ext_vector_type(2))); typedef __bf16 bf16x2_t __attribute__((ext_vector_type(2)));
__device__ __forceinline__ unsigned cvt_pk_bf16(float lo, float hi) { f32x2_t v = {lo, hi}; bf16x2_t b = __builtin_convertvector(v, bf16x2_t); return __builtin_bit_cast(unsigned, b); }
typedef float f32x2 __attribute__((ext_vector_type(2)));
constexpr int MPR = 16384;
constexpr float EPS = 1e-6f, LOG2E = 1.4426950408889634f, QSCALE = 0.125f * 1.4426950408889634f;
__device__ __forceinline__ float sigm(float x) { return __builtin_amdgcn_rcpf(1.0f + __builtin_amdgcn_exp2f(-x * LOG2E)); }
__device__ __forceinline__ float dot4(f32x4 a) { return (a[0] * a[0] + a[1] * a[1]) + (a[2] * a[2] + a[3] * a[3]); }
typedef unsigned u32x2 __attribute__((ext_vector_type(2)));
__device__ __forceinline__ u32x4 pack8(f32x4 a, f32x4 b) { u32x4 w; w.x = cvt_pk_bf16(a[0], a[1]); w.y = cvt_pk_bf16(a[2], a[3]); w.z = cvt_pk_bf16(b[0], b[1]); w.w = cvt_pk_bf16(b[2], b[3]); return w; }

struct EpiIn {
    static constexpr bool PERM = true, AFTER_DRAIN = false;
    bf16_t* QB; float* HLF;
    static constexpr size_t BSTRIDE = (size_t)17 * 1024 * 1024 / 2; float *okp, *oks;   const float* rstd1; const float* gqk; const float* hlb;
    __device__ __forceinline__ void operator()(const f32x4 (&acc)[2][2][4][2], const Unit& u, int wr, int wc, int fr, int fq) const {
        const int type = u.pn >> 1;
        const int cl = (u.pn & 1) * 256 + wc * 64 + 8 * fq;
        const int row0 = u.pm * BM + wr * 64 + fr;
        float* const kvo = u.pm < 64 ? okp + (size_t)row0 * 512 : oks + (size_t)(row0 - MPR) * 512;
        const size_t vofs = u.pm < 64 ? (size_t)8388608 : (size_t)262144;
        float rs[2][4];
#pragma unroll
        for (int ai = 0; ai < 2; ++ai)
#pragma unroll
            for (int m = 0; m < 4; ++m) rs[ai][m] = rstd1[row0 + ai * HALF + m * 16];
        asm volatile("" : "+v"(rs[0][0]), "+v"(rs[0][1]), "+v"(rs[0][2]), "+v"(rs[0][3]), "+v"(rs[1][0]), "+v"(rs[1][1]), "+v"(rs[1][2]), "+v"(rs[1][3]));
        if (type <= 1) {
            const float* g = gqk + type * 128 + (wc & 1) * 64 + 8 * fq;
            f32x4 gv[2][2];
#pragma unroll
            for (int bj = 0; bj < 2; ++bj)
#pragma unroll
                for (int n = 0; n < 2; ++n) gv[bj][n] = *(const f32x4*)(g + 32 * bj + 4 * n);
            const float sc = type == 0 ? QSCALE : 1.0f;
#pragma unroll
            for (int ai = 0; ai < 2; ++ai)
#pragma unroll
                for (int m = 0; m < 4; ++m) {
                    const int row = row0 + ai * HALF + m * 16; f32x4 v[2][2]; float ss = 0.f;
#pragma unroll
                    for (int bj = 0; bj < 2; ++bj)
#pragma unroll
                        for (int n = 0; n < 2; ++n) { v[bj][n] = acc[ai][bj][m][n] * rs[ai][m]; ss += dot4(v[bj][n]); }
                    ss += __shfl_xor(ss, 16); ss += __shfl_xor(ss, 32);
                    const float rn = rsqrtf(ss * (1.0f / 64.0f) + EPS);
#pragma unroll
                    for (int bj = 0; bj < 2; ++bj) {
                        const f32x4 a = v[bj][0] * rn * gv[bj][0], b = v[bj][1] * rn * gv[bj][1];
                        if (type == 1) { float* ko = kvo + (size_t)(ai * HALF + m * 16) * 512 + cl + 32 * bj; *(f32x4*)ko = a; *(f32x4*)(ko + 4) = b; }
                        *(u32x4*)(QB + (size_t)type * BSTRIDE + (size_t)row * 512 + cl + 32 * bj) = pack8(a * sc, b * sc);
                    }
                }
        } else if (type == 4) {
            f32x4 lb[2][2];
#pragma unroll
            for (int bj = 0; bj < 2; ++bj)
#pragma unroll
                for (int n = 0; n < 2; ++n) { const f32x4 a = *(const f32x4*)(hlb + cl + 32 * bj + 4 * n), b = *(const f32x4*)(hlb + 512 + cl + 32 * bj + 4 * n);
#pragma unroll
                    for (int j = 0; j < 4; ++j) lb[bj][n][j] = sigm(a[j] - b[j]); }
#pragma unroll
            for (int ai = 0; ai < 2; ++ai)
#pragma unroll
                for (int m = 0; m < 4; ++m) {
                    const int row = row0 + ai * HALF + m * 16;
#pragma unroll
                    for (int bj = 0; bj < 2; ++bj)
#pragma unroll
                        for (int n = 0; n < 2; ++n) { f32x4 o;
#pragma unroll
                            for (int j = 0; j < 4; ++j) { const float z = acc[ai][bj][m][n][j] * rs[ai][m]; const float f = lb[bj][n][j] + (1.0f - lb[bj][n][j]) * sigm(z); o[j] = logf(f); }
                            *(f32x4*)(HLF + (size_t)row * 512 + cl + 32 * bj + 4 * n) = o; }
                }
        } else {
            bf16_t* dst = QB + (size_t)(type - (type > 4 ? 1 : 0)) * BSTRIDE;
#pragma unroll
            for (int ai = 0; ai < 2; ++ai)
#pragma unroll
                for (int m = 0; m < 4; ++m) {
                    const int row = row0 + ai * HALF + m * 16;
#pragma unroll
                    for (int bj = 0; bj < 2; ++bj) {
                        f32x4 a = acc[ai][bj][m][0] * rs[ai][m], b = acc[ai][bj][m][1] * rs[ai][m];
                        if (type == 2) { float* vo = kvo + vofs + (size_t)(ai * HALF + m * 16) * 512 + cl + 32 * bj; *(f32x4*)vo = a; *(f32x4*)(vo + 4) = b; }
                        if (type == 6) {
#pragma unroll
                            for (int j = 0; j < 4; ++j) { a[j] = a[j] * sigm(a[j]); b[j] = b[j] * sigm(b[j]); } }
                        *(u32x4*)(dst + (size_t)row * 512 + cl + 32 * bj) = pack8(a, b);
                    }
                }
        }
    }
};

struct EpiOut {
    static constexpr bool PERM = true, AFTER_DRAIN = false;
    const float *xp, *xs; float *yp, *ys; bf16_t* X1B; float* SSQP;
    __device__ __forceinline__ void operator()(const f32x4 (&acc)[2][2][4][2], const Unit& u, int wr, int wc, int fr, int fq) const {
        const int row0 = u.pm * BM + wr * 64 + fr, col0 = u.pn * BM + wc * 32 + 8 * fq;
        const float* const xb = u.pm < 64 ? xp + (size_t)row0 * 1024 : xs + (size_t)(row0 - MPR) * 1024; float* const yb = u.pm < 64 ? yp + (size_t)row0 * 1024 : ys + (size_t)(row0 - MPR) * 1024;
#pragma unroll
        for (int ai = 0; ai < 2; ++ai)
#pragma unroll
            for (int m = 0; m < 4; ++m) {
                const int row = row0 + ai * HALF + m * 16;
                const float* xin = xb + (size_t)(ai * HALF + m * 16) * 1024;
                float* yo = yb + (size_t)(ai * HALF + m * 16) * 1024;
                float ss = 0.f;
#pragma unroll
                for (int bj = 0; bj < 2; ++bj) { const int col = col0 + bj * HALF;
                    const f32x4 a = *(const f32x4*)(xin + col) + acc[ai][bj][m][0], b = *(const f32x4*)(xin + col + 4) + acc[ai][bj][m][1];
                    *(f32x4*)(yo + col) = a; *(f32x4*)(yo + col + 4) = b; ss += dot4(a) + dot4(b);
                    *(u32x4*)(X1B + (size_t)row * 1024 + col) = pack8(a, b); }
                ss += __shfl_xor(ss, 16); ss += __shfl_xor(ss, 32);
                if (fq == 0) SSQP[(size_t)row * 16 + u.pn * 4 + wc] = ss;
            }
    }
};

struct EpiDown {
    static constexpr bool PERM = true, AFTER_DRAIN = false;
    float *yp, *ys;
    __device__ __forceinline__ void operator()(const f32x4 (&acc)[2][2][4][2], const Unit& u, int wr, int wc, int fr, int fq) const {
        const int row0 = u.pm * BM + wr * 64 + fr, col0 = u.pn * BM + wc * 32 + 8 * fq;
        float* const yb = u.pm < 64 ? yp + (size_t)row0 * 1024 : ys + (size_t)(row0 - MPR) * 1024;
#pragma unroll
        for (int ai = 0; ai < 2; ++ai)
#pragma unroll
            for (int m = 0; m < 4; ++m) {
                float* yo = yb + (size_t)(ai * HALF + m * 16) * 1024;
#pragma unroll
                for (int bj = 0; bj < 2; ++bj) { float* p = yo + col0 + bj * HALF;
                    f32x4 a = *(const f32x4*)p + acc[ai][bj][m][0], b = *(const f32x4*)(p + 4) + acc[ai][bj][m][1];
#ifdef DIAG_T1
                    if (u.pm < 64) { a = a * 1.036f; b = b * 1.036f; }
#endif
                    *(f32x4*)p = a; *(f32x4*)(p + 4) = b; }
            }
    }
};

struct EpiGU {
    static constexpr bool PERM = true, AFTER_DRAIN = false;
    bf16_t* G; const float* SSQP; const float *cw, *cb, *sconv; float *HALO_A, *HALO_U, *LASTA, *ocp, *ocs; PG8_LAS float* xch;
    __device__ __forceinline__ void operator()(const f32x4 (&acc)[2][2][4][2], const Unit& u, int wr, int wc, int fr, int fq) const {
        const int colt = u.pn * 128 + 32 * wc + 8 * fq;
        const int row0 = u.pm * BM + wr * 64 + fr;
        float rs[2][4];
#pragma unroll
        for (int ai = 0; ai < 2; ++ai)
#pragma unroll
            for (int m = 0; m < 4; ++m) { const f32x4* p = (const f32x4*)(SSQP + (size_t)(row0 + ai * HALF + m * 16) * 16); const f32x4 s = (p[0] + p[1]) + (p[2] + p[3]);
                rs[ai][m] = rsqrtf(((s[0] + s[1]) + (s[2] + s[3])) * (1.0f / 1024.0f) + EPS); }
        if (u.pm < 64) {
            if (fr >= 14) {
#pragma unroll
                for (int ai = 0; ai < 2; ++ai)
#pragma unroll
                    for (int n = 0; n < 2; ++n) *(PG8_LAS f32x4*)(xch + (((wr * 4 + wc) * 8 + (fr - 14) * 4 + fq) * 16 + ai * 8 + n * 4)) = acc[ai][0][3][n] * rs[ai][3];
            }
            asm volatile("s_waitcnt lgkmcnt(0)" ::: "memory"); __builtin_amdgcn_s_barrier(); asm volatile("" ::: "memory");
#pragma unroll
            for (int n = 0; n < 2; ++n) {
                const f32x4 w0 = *(const f32x4*)(cw + colt + 4 * n), w1 = *(const f32x4*)(cw + 2816 + colt + 4 * n), w2 = *(const f32x4*)(cw + 5632 + colt + 4 * n), bb = *(const f32x4*)(cb + colt + 4 * n);
#pragma unroll
                for (int ai = 0; ai < 2; ++ai) {
                    f32x4 prevA = {0.f, 0.f, 0.f, 0.f};
                    const bool has_prev = (wr == 1) || (ai == 1);
                    #ifndef DIAG_T3
                    if (has_prev && fr >= 14) { const int pw = (wr == 1 ? 0 : 4) + wc, pai = (wr == 1) ? ai : 0; prevA = *(const PG8_LAS f32x4*)(xch + ((pw * 8 + (fr - 14) * 4 + fq) * 16 + pai * 8 + n * 4)); }
#endif
#pragma unroll
                    for (int m = 0; m < 4; ++m) {
                        const int row = row0 + ai * HALF + m * 16;
                        const f32x4 a = acc[ai][0][m][n] * rs[ai][m], uu = acc[ai][1][m][n] * rs[ai][m]; f32x4 gg;
#pragma unroll
                        for (int j = 0; j < 4; ++j) {
                            const float up1 = __shfl_up(a[j], 1, 16), up2 = __shfl_up(a[j], 2, 16), t15 = __shfl(prevA[j], 15, 16), t14 = __shfl(prevA[j], 14, 16);
                            const float p1 = fr == 0 ? t15 : up1, p2 = fr == 0 ? t14 : (fr == 1 ? t15 : up2);
                            const float c = bb[j] + w0[j] * p2 + w1[j] * p1 + w2[j] * a[j];
                            gg[j] = c * sigm(c) * uu[j];
                        }
                        *(u32x2*)(G + (size_t)row * 2816 + colt + 4 * n) = (u32x2){cvt_pk_bf16(gg[0], gg[1]), cvt_pk_bf16(gg[2], gg[3])};
                        if (ai == 0 && m == 0 && wr == 0 && fr < 2) { *(f32x4*)(HALO_A + (size_t)(u.pm * 2 + fr) * 2816 + colt + 4 * n) = a; *(f32x4*)(HALO_U + (size_t)(u.pm * 2 + fr) * 2816 + colt + 4 * n) = uu; }
                        if (ai == 1 && m == 3 && wr == 1 && fr >= 14) { *(f32x4*)(LASTA + (size_t)(u.pm * 2 + fr - 14) * 2816 + colt + 4 * n) = a;
                            if ((u.pm & 31) == 31) *(f32x4*)(ocp + (size_t)((u.pm >> 5) * 2 + fr - 14) * 2816 + colt + 4 * n) = a; }
                        prevA = a;
                    }
                }
            }
        } else {
#pragma unroll
            for (int n = 0; n < 2; ++n) {
                const f32x4 w0 = *(const f32x4*)(cw + colt + 4 * n), w1 = *(const f32x4*)(cw + 2816 + colt + 4 * n), w2 = *(const f32x4*)(cw + 5632 + colt + 4 * n), bb = *(const f32x4*)(cb + colt + 4 * n);
#pragma unroll
                for (int ai = 0; ai < 2; ++ai)
#pragma unroll
                    for (int m = 0; m < 4; ++m) {
                        const int row = row0 + ai * HALF + m * 16, rl = row - MPR, bs = rl >> 2, t = rl & 3;
                        const f32x4 a = acc[ai][0][m][n] * rs[ai][m], uu = acc[ai][1][m][n] * rs[ai][m]; f32x4 gg, s0 = {0.f, 0.f, 0.f, 0.f}, s1 = {0.f, 0.f, 0.f, 0.f};
                        const float* sc = sconv + (size_t)bs * 2 * 2816 + colt + 4 * n;
                        if (t == 0) s0 = *(const f32x4*)sc;
                        if (t <= 1) s1 = *(const f32x4*)(sc + 2816);
#pragma unroll
                        for (int j = 0; j < 4; ++j) {
                            const float up1 = __shfl_up(a[j], 1, 16), up2 = __shfl_up(a[j], 2, 16);
                            const float p1 = t == 0 ? s1[j] : up1, p2 = t == 0 ? s0[j] : (t == 1 ? s1[j] : up2);
                            const float c = bb[j] + w0[j] * p2 + w1[j] * p1 + w2[j] * a[j];
                            gg[j] = c * sigm(c) * uu[j];
                        }
                        *(u32x2*)(G + (size_t)row * 2816 + colt + 4 * n) = (u32x2){cvt_pk_bf16(gg[0], gg[1]), cvt_pk_bf16(gg[2], gg[3])};
                        if (t >= 2) *(f32x4*)(ocs + (size_t)(bs * 2 + t - 2) * 2816 + colt + 4 * n) = a;
                    }
            }
        }
    }
};
template <class Epi, class Sched, bool ALIGN_EPI = false, bool SP2 = false>
__device__ __forceinline__ void gemm_phase(PG8_LAS unsigned char* lds, const Gemm g, const Sched& S, const Epi& E) {
    int tid_ = threadIdx.x; asm volatile("" : "+v"(tid_));
    const int tid = tid_, wid = __builtin_amdgcn_readfirstlane(tid >> 6), lane = tid & 63, wr = wid >> 2, wc = wid & 3, fr = lane & 15, fq = lane >> 4;
    const int K = g.K, nt = K / BK;
    unsigned voffA[2], voffB[2];
#pragma unroll
    for (int i = 0; i < 2; ++i) { int R, C; stage_rc(tid * 16 + i * 8192, R, C); const int Rb = Epi::PERM ? ((R & ~31) + perm32(R & 31)) : R;
        voffA[i] = (unsigned)(R * K + C) * 2u; voffB[i] = (unsigned)(Rb * K + C) * 2u; }
    const size_t kstep = (size_t)(BK * 2);
    const size_t hstep = (size_t)HALF * K * 2;
    const size_t tstep = 2 * hstep;
    const unsigned ldsw = (unsigned)wid * 1024u;
    const int aoff = lds_byte(wr * 64 + fr, fq * 8), boff = lds_byte(wc * 32 + fr, fq * 8);
#define PG8_SA(b, h) (((b) * 2 + (h)) * HTB)
#define PG8_SB(b, h) ((4 + (b) * 2 + (h)) * HTB)
#define PG8_STAGE(bufoff, gbase, voff) do { _Pragma("unroll") for (int _i = 0; _i < 2; ++_i) \
        __builtin_amdgcn_global_load_lds((const unsigned*)((const char*)(gbase) + (voff)[_i]), (PG8_LAS unsigned*)(lds + (bufoff) + ldsw + _i * 8192), 16, 0, 0); } while (0)
#define PG8_LDA(dst, b, h) do { _Pragma("unroll") for (int m = 0; m < 4; ++m) _Pragma("unroll") for (int k = 0; k < 2; ++k) dst[m][k] = *(const PG8_LAS bf16x8*)(lds + PG8_SA(b, h) + aoff + m * 2048 + k * 1024); } while (0)
#define PG8_LDB(dst, b, h) do { _Pragma("unroll") for (int n = 0; n < 2; ++n) _Pragma("unroll") for (int k = 0; k < 2; ++k) dst[n][k] = *(const PG8_LAS bf16x8*)(lds + PG8_SB(b, h) + boff + n * 2048 + k * 1024); } while (0)
#define PG8_MMA(ai, bj, At, Bt) do { __builtin_amdgcn_s_setprio(1); _Pragma("unroll") for (int m = 0; m < 4; ++m) _Pragma("unroll") for (int n = 0; n < 2; ++n) _Pragma("unroll") for (int k = 0; k < 2; ++k) \
        acc[ai][bj][m][n] = __builtin_amdgcn_mfma_f32_16x16x32_bf16(Bt[n][k], At[m][k], acc[ai][bj][m][n], 0, 0, 0); __builtin_amdgcn_s_setprio(0); } while (0)
#define PG8_WAIT_V(n) asm volatile("s_waitcnt vmcnt(" #n ")" ::: "memory")
#define PG8_WAIT_L(n) asm volatile("s_waitcnt lgkmcnt(" #n ")" ::: "memory")
#define PG8_BAR __builtin_amdgcn_s_barrier()
#define PG8_SCHED __builtin_amdgcn_sched_barrier(0)
    Unit cur, nxt; int ui = 0;
    if (!S.next(0, cur)) return;
    f32x4 acc[2][2][4][2];
#pragma unroll
    for (int a = 0; a < 2; ++a)
#pragma unroll
        for (int b = 0; b < 2; ++b)
#pragma unroll
            for (int m = 0; m < 4; ++m)
#pragma unroll
                for (int n = 0; n < 2; ++n) acc[a][b][m][n] = (f32x4){0.f, 0.f, 0.f, 0.f};
    bf16x8 At[4][2], B0[2][2], B1[2][2];
    const char* cA = (const char*)g.A + (size_t)cur.pm * tstep; const char* cB = (const char*)g.Bt + (size_t)cur.pn * tstep;
    S.a_ready(cur);
    if constexpr (SP2) {
        PG8_STAGE(PG8_SB(0, 0), cB, voffB); PG8_STAGE(PG8_SB(0, 1), cB + hstep, voffB); PG8_STAGE(PG8_SA(0, 0), cA, voffA); PG8_STAGE(PG8_SA(0, 1), cA + hstep, voffA);
        if (wr == 1) PG8_BAR;
        PG8_WAIT_V(2); PG8_BAR;
        PG8_STAGE(PG8_SB(1, 0), cB + kstep, voffB); PG8_STAGE(PG8_SA(1, 0), cA + kstep, voffA); PG8_STAGE(PG8_SB(1, 1), cB + hstep + kstep, voffB);
        PG8_WAIT_V(6); PG8_BAR;
    } else {
        PG8_STAGE(PG8_SB(0, 0), cB, voffB); PG8_STAGE(PG8_SA(0, 0), cA, voffA); PG8_STAGE(PG8_SB(0, 1), cB + hstep, voffB); PG8_STAGE(PG8_SA(0, 1), cA + hstep, voffA);
        if (wr == 1) PG8_BAR;
        PG8_WAIT_V(4); PG8_BAR;
        PG8_STAGE(PG8_SB(1, 0), cB + kstep, voffB); PG8_STAGE(PG8_SA(1, 0), cA + kstep, voffA); PG8_STAGE(PG8_SB(1, 1), cB + hstep + kstep, voffB);
        PG8_WAIT_V(6); PG8_BAR;
    }
    for (;;) {
        const bool has_next = S.next(ui + 1, nxt);
        const char* nA = has_next ? (const char*)g.A + (size_t)nxt.pm * tstep : cA; const char* nB = has_next ? (const char*)g.Bt + (size_t)nxt.pn * tstep : cB;
        for (int t = 0; t < nt; t += 2) {
            const bool last = (t == nt - 2);
            const char* a1 = cA + (size_t)(t + 1) * kstep;
            const char* a2 = last ? nA : cA + (size_t)(t + 2) * kstep; const char* b2 = last ? nB : cB + (size_t)(t + 2) * kstep;
            const char* a3 = a2 + kstep; const char* b3 = b2 + kstep;
            if (last && has_next) S.a_ready(nxt);
            if constexpr (SP2) {
            PG8_LDB(B0, 0, 0); PG8_LDB(B1, 0, 1); PG8_SCHED; PG8_LDA(At, 0, 0); PG8_STAGE(PG8_SA(1, 1), a1 + hstep, voffA);
            PG8_WAIT_V(8); PG8_WAIT_L(0); PG8_BAR; PG8_MMA(0, 0, At, B0); PG8_MMA(0, 1, At, B1); PG8_BAR; PG8_SCHED;
            PG8_LDA(At, 0, 1); PG8_STAGE(PG8_SB(0, 0), b2, voffB); PG8_STAGE(PG8_SB(0, 1), b2 + hstep, voffB); PG8_STAGE(PG8_SA(0, 0), a2, voffA);
            PG8_WAIT_V(8); PG8_WAIT_L(0); PG8_BAR; PG8_MMA(1, 0, At, B0); PG8_MMA(1, 1, At, B1); PG8_BAR; PG8_SCHED;
            PG8_LDB(B0, 1, 0); PG8_LDB(B1, 1, 1); PG8_SCHED; PG8_LDA(At, 1, 0); PG8_STAGE(PG8_SA(0, 1), a2 + hstep, voffA);
            PG8_WAIT_V(8); PG8_WAIT_L(0); PG8_BAR; PG8_MMA(0, 0, At, B0); PG8_MMA(0, 1, At, B1); PG8_BAR; PG8_SCHED;
            PG8_LDA(At, 1, 1); PG8_STAGE(PG8_SB(1, 0), b3, voffB); PG8_STAGE(PG8_SB(1, 1), b3 + hstep, voffB); PG8_STAGE(PG8_SA(1, 0), a3, voffA);
            PG8_WAIT_V(8); PG8_WAIT_L(0); PG8_BAR; PG8_MMA(1, 0, At, B0); PG8_MMA(1, 1, At, B1); PG8_BAR; PG8_SCHED;
            } else {
            PG8_LDB(B0, 0, 0); PG8_SCHED; PG8_LDA(At, 0, 0); PG8_STAGE(PG8_SA(1, 1), a1 + hstep, voffA);
            PG8_WAIT_L(8); PG8_BAR; PG8_WAIT_L(0); PG8_MMA(0, 0, At, B0); PG8_BAR; PG8_SCHED;
            PG8_LDB(B1, 0, 1); PG8_STAGE(PG8_SB(0, 0), b2, voffB);
            PG8_BAR; PG8_WAIT_L(0); PG8_MMA(0, 1, At, B1); PG8_BAR;
            PG8_LDA(At, 0, 1); PG8_STAGE(PG8_SA(0, 0), a2, voffA);
            PG8_BAR; PG8_WAIT_L(0); PG8_MMA(1, 0, At, B0); PG8_BAR; PG8_SCHED;
            PG8_STAGE(PG8_SB(0, 1), b2 + hstep, voffB);
            PG8_WAIT_V(6); PG8_BAR; PG8_MMA(1, 1, At, B1); PG8_BAR;
            PG8_LDB(B0, 1, 0); PG8_SCHED; PG8_LDA(At, 1, 0); PG8_STAGE(PG8_SA(0, 1), a2 + hstep, voffA);
            PG8_WAIT_L(8); PG8_BAR; PG8_WAIT_L(0); PG8_MMA(0, 0, At, B0); PG8_BAR; PG8_SCHED;
            PG8_LDB(B1, 1, 1); PG8_STAGE(PG8_SB(1, 0), b3, voffB);
            PG8_BAR; PG8_WAIT_L(0); PG8_MMA(0, 1, At, B1); PG8_BAR;
            PG8_LDA(At, 1, 1); PG8_STAGE(PG8_SA(1, 0), a3, voffA);
            PG8_BAR; PG8_WAIT_L(0); PG8_MMA(1, 0, At, B0); PG8_BAR; PG8_SCHED;
            PG8_STAGE(PG8_SB(1, 1), b3 + hstep, voffB);
            PG8_WAIT_V(6); PG8_BAR; PG8_MMA(1, 1, At, B1); PG8_BAR;
            }
        }
        if constexpr (ALIGN_EPI) { if (wr == 0) PG8_BAR; }
        if constexpr (!Epi::AFTER_DRAIN) { int l_; asm volatile("v_mbcnt_lo_u32_b32 %0, -1, 0\n\tv_mbcnt_hi_u32_b32 %0, -1, %0" : "=v"(l_)); E(acc, cur, wr, wc, l_ & 15, l_ >> 4); S.done(cur); }
        if (!has_next) break;
#pragma unroll
        for (int a = 0; a < 2; ++a)
#pragma unroll
            for (int b = 0; b < 2; ++b)
#pragma unroll
                for (int m = 0; m < 4; ++m)
#pragma unroll
                    for (int n = 0; n < 2; ++n) acc[a][b][m][n] = (f32x4){0.f, 0.f, 0.f, 0.f};
        cur = nxt; cA = nA; cB = nB; ++ui;
        if constexpr (ALIGN_EPI) { if (wr == 1) PG8_BAR; }
    }
    PG8_WAIT_V(0);
    if constexpr (!ALIGN_EPI) { if (wr == 0) PG8_BAR; }
    PG8_BAR;
    if constexpr (Epi::AFTER_DRAIN) { E.fused(acc, cur, wr, wc, fr, fq, lds, wid, lane); S.done(cur); }
#undef PG8_SA
#undef PG8_SB
#undef PG8_STAGE
#undef PG8_LDA
#undef PG8_LDB
#undef PG8_MMA
#undef PG8_WAIT_V
#undef PG8_WAIT_L
#undef PG8_BAR
#undef PG8_SCHED
}
}

#ifndef PG8_SP2
#define PG8_SP2 true
#endif
#ifndef PG8_ALIGN
#define PG8_ALIGN true
#endif
constexpr int NWAVES = 8;
constexpr int DM = 1024, TP = 8192, NBP = 2, MP = NBP * TP, NBS = 128, TS = 4, MS = NBS * TS, MALL = MP + MS;
constexpr int NIN = 3584, DFF = 2816, NPAGES = 16, PAGE = 128, PAST = 2048;
constexpr float EPSF = 1e-6f, LOG2E_F = 1.4426950408889634f;
constexpr size_t O_YP = 0, O_YS = 16777216, O_KP = 17301504, O_VP = 25690112, O_HP = 34078720, O_CP = 34209792, O_KS = 34221056, O_VS = 34483200, O_HS = 34745344, O_CS = 43133952, O_END = 43854848;
constexpr size_t MiB = 1u << 20;
constexpr size_t WS_CTL = 0, CTL_ZERO_BYTES = 1 * MiB;
constexpr size_t WS_WIN = 2 * MiB;
constexpr size_t WS_WOUT = 10 * MiB;
constexpr size_t WS_WGU = 12 * MiB;
constexpr size_t WS_WDN = 24 * MiB;
constexpr size_t WS_RSTD1 = 30 * MiB;
constexpr size_t WS_SSQP = 31 * MiB;
constexpr size_t WS_HALOA = 33 * MiB, WS_HALOU = 35 * MiB, WS_LASTA = 37 * MiB;
constexpr size_t WS_DTOT = 39 * MiB;
constexpr size_t WS_XB = 40 * MiB;
constexpr size_t WS_QB = 74 * MiB, WS_KB = 91 * MiB, WS_VB = 108 * MiB, WS_HQ = 125 * MiB, WS_HV = 142 * MiB, WS_HG = 159 * MiB;
constexpr size_t WS_HLF = 176 * MiB;
constexpr size_t WS_MIX = 210 * MiB;
constexpr size_t WS_X1B = 244 * MiB;
constexpr size_t WS_UBUF = 278 * MiB;
constexpr size_t WS_SST = 295 * MiB;
constexpr size_t WS_G = 312 * MiB;
constexpr size_t WS_END = 404 * MiB;
constexpr int CW_TMO = 0, CW_BAR = 4096;
constexpr int RING_OFF = 0, RING_BYTES = 131072;
constexpr int LDSCTL_OFF = RING_BYTES, MISC_OFF = LDSCTL_OFF + 320;
constexpr int BL_OFF = RING_BYTES + 512;
constexpr int SCAL_OFF = BL_OFF + 2048;
constexpr int XCH_OFF = SCAL_OFF + 128;
constexpr int ALS_OFF = XCH_OFF + 4096;
constexpr int LDS_BYTES = 147456;
static_assert(ALS_OFF + 1024 <= LDS_BYTES, "LDS map");

#define GAS __attribute__((address_space(1)))
#define LAS __attribute__((address_space(3)))
typedef unsigned short bf16;
typedef unsigned v4u __attribute__((ext_vector_type(4)));
typedef unsigned v2u __attribute__((ext_vector_type(2)));
typedef float f32x4 __attribute__((ext_vector_type(4)));
typedef float f32x16 __attribute__((ext_vector_type(16)));
typedef short bf16x8 __attribute__((ext_vector_type(8)));
typedef short s16x4 __attribute__((ext_vector_type(4)));
typedef GAS unsigned gu32;
#define RLX_AGENT __ATOMIC_RELAXED, __HIP_MEMORY_SCOPE_AGENT
#define LDS_WAIT() asm volatile("s_waitcnt lgkmcnt(0)" ::: "memory")
#define VM_WAIT() asm volatile("s_waitcnt vmcnt(0)" ::: "memory")
#define WG_SYNC() do { asm volatile("s_waitcnt vmcnt(0) lgkmcnt(0)" ::: "memory"); __builtin_amdgcn_s_barrier(); asm volatile("" ::: "memory"); } while (0)
#define LDS_SYNC() do { asm volatile("s_waitcnt lgkmcnt(0)" ::: "memory"); __builtin_amdgcn_s_barrier(); asm volatile("" ::: "memory"); } while (0)
__device__ __forceinline__ unsigned f2bf(float f) { unsigned u = __builtin_bit_cast(unsigned, f); return (u + 0x7fffu + ((u >> 16) & 1u)) >> 16; }
__device__ __forceinline__ unsigned pk2(float lo, float hi) { return pg8::cvt_pk_bf16(lo, hi); }
__device__ __forceinline__ float bf2f(unsigned short h) { return __builtin_bit_cast(float, (unsigned)h << 16); }
__device__ __forceinline__ float sigm_f(float x) { return __builtin_amdgcn_rcpf(1.0f + __builtin_amdgcn_exp2f(-x * LOG2E_F)); }
__device__ __forceinline__ float ex2(float x) { return __builtin_amdgcn_exp2f(x); }
__device__ __forceinline__ int crow(int r, int hi) { return (r & 3) + 8 * (r >> 2) + 4 * hi; }
#define XB_TMO      128
#define XB_XCNT(j)  (256  + 64 * (j))
#define XB_XSUB(j)  (1280 + 64 * (j))
#define XB_XGEN(j)  (2304 + 64 * (j))
#define XB_TOP      3328
#define XB_TOPGEN   3392
#define XCD_BAR_WORDS 3456
#define XB_SPIN_CAP (1u << 18)

__device__ __forceinline__ unsigned xb_ld(unsigned* p)              { return __hip_atomic_load(p, __ATOMIC_RELAXED, __HIP_MEMORY_SCOPE_AGENT); }
__device__ __forceinline__ unsigned xb_add(unsigned* p, unsigned v) { return __hip_atomic_fetch_add(p, v, __ATOMIC_RELAXED, __HIP_MEMORY_SCOPE_AGENT); }
__device__ __forceinline__ unsigned xb_xcc_id() { return (unsigned)__builtin_amdgcn_s_getreg((3 << 11) | 20) & 0xFu; }
#define XB_SPIN(cond, bar) do { unsigned _sp = 0; while (cond) { __builtin_amdgcn_s_sleep(1); \
    if ((++_sp & 255u) == 0u) { if (xb_ld(&(bar)[XB_TMO])) break; if (_sp > XB_SPIN_CAP) { atomicAdd(&(bar)[XB_TMO], 1u); break; } } } } while (0)

struct XcdBarrier {
    unsigned* bar; unsigned x;
    volatile LAS unsigned* st;
};

__device__ __forceinline__ XcdBarrier xcd_barrier_post(unsigned* bar, volatile LAS unsigned* st) {
    XcdBarrier b; b.bar = bar; b.x = xb_xcc_id(); b.st = st;
    if (threadIdx.x == 0) (void)xb_add(&bar[XB_XCNT(b.x)], 1u);
    return b;
}
__device__ __forceinline__ void xcd_barrier_complete(unsigned* bar, unsigned x, unsigned& nloc, unsigned& nx) {
    const unsigned G = gridDim.x * gridDim.y * gridDim.z;
    unsigned sum, cnt, mine, sp = 0u;
    for (;;) {
        sum = 0u; cnt = 0u; mine = 0u;
#pragma unroll
        for (unsigned j = 0; j < 16; ++j) { const unsigned c = xb_ld(&bar[XB_XCNT(j)]); sum += c; cnt += (c > 0u) ? 1u : 0u; mine = (j == x) ? c : mine; }
        if (sum == G) break;
        __builtin_amdgcn_s_sleep(1);
        if ((++sp & 255u) == 0u) { if (xb_ld(&bar[XB_TMO])) break; if (sp > XB_SPIN_CAP) { atomicAdd(&bar[XB_TMO], 1u); break; } }
    }
    nloc = mine > 0u ? mine : 1u; nx = cnt > 0u ? cnt : 1u;
}

__device__ __forceinline__ void xcd_barrier(const XcdBarrier& b) {
    asm volatile("s_waitcnt vmcnt(0)" ::: "memory");
    __syncthreads();
    if (threadIdx.x == 0) {
        unsigned* bar = b.bar;
        __builtin_amdgcn_s_waitcnt(0);
        unsigned nloc = b.st[0], nx = b.st[1];
        if (nloc == 0u) { xcd_barrier_complete(bar, b.x, nloc, nx); b.st[0] = nloc; b.st[1] = nx; }
        const unsigned old = xb_add(&bar[XB_XSUB(b.x)], 1u);
        const unsigned gen = old / nloc;
        if (old + 1u == (gen + 1u) * nloc) {
            __builtin_amdgcn_fence(__ATOMIC_RELEASE, "agent");
            asm volatile("s_waitcnt vmcnt(0)" ::: "memory");
            const unsigned og = xb_add(&bar[XB_TOP], 1u);
            const unsigned tg = og / nx;
            if (og + 1u == (tg + 1u) * nx) xb_add(&bar[XB_TOPGEN], 1u);
            else XB_SPIN(xb_ld(&bar[XB_TOPGEN]) == tg, bar);
            __builtin_amdgcn_fence(__ATOMIC_ACQUIRE, "agent");
            xb_add(&bar[XB_XGEN(b.x)], 1u);
            asm volatile("s_waitcnt vmcnt(0)" ::: "memory");
        } else {
            XB_SPIN(xb_ld(&bar[XB_XGEN(b.x)]) == gen, bar);
            __builtin_amdgcn_fence(__ATOMIC_ACQUIRE, "agent");
            asm volatile("s_waitcnt vmcnt(0)" ::: "memory");
        }
    }
    __syncthreads();
}

__device__ __forceinline__ float wave_sum(float v) {
#pragma unroll
    for (int o = 1; o < 64; o <<= 1) v += __shfl_xor(v, o);
    return v;
}
template <class KS>
__device__ __forceinline__ void p0_transpose_item(const float* W, int K, int N, bf16* WT, int kb, int nb, int prow, LAS float* scr, int lane, const KS& ks) {
    const int k0 = 64 * kb, n0 = 32 * nb;
#pragma unroll 8
    for (int i = 0; i < 32; ++i) { const int kk = 2 * i + (lane >> 5); scr[kk * 33 + (lane & 31)] = W[(size_t)(k0 + kk) * N + n0 + (lane & 31)] * ks(k0 + kk); }
    LDS_WAIT(); asm volatile("" ::: "memory");
    const int c = lane & 7;
#pragma unroll
    for (int j = 0; j < 4; ++j) { const int n = (lane >> 3) + 8 * j; const LAS float* s = scr + (8 * c) * 33 + n;
        v4u o; o.x = pk2(s[0 * 33], s[1 * 33]); o.y = pk2(s[2 * 33], s[3 * 33]); o.z = pk2(s[4 * 33], s[5 * 33]); o.w = pk2(s[6 * 33], s[7 * 33]);
        *(GAS v4u*)(WT + (size_t)(prow + n) * K + k0 + 8 * c) = o; }
    LDS_WAIT(); asm volatile("" ::: "memory");
}
struct PIn {
    const float *xp, *xs, *ck, *cv; const int* pt; const float *sh, *sconv, *relb, *g1, *win, *gqk, *lqk, *subg, *hlb, *ong, *wout, *g2, *wg, *wu, *cw, *cb, *wd;
};
constexpr int H_QT = 0, H_KI = 17408, H_KET = 34816, H_VT = 53248, H_ST = 71680, H_P = 106496, H_DEC = 115712, H_TOT = 116224, H_END = 118272;
static_assert(H_END <= RING_BYTES, "hgrn LDS");
#define MFMA32(a, b, c) __builtin_amdgcn_mfma_f32_32x32x16_bf16((a), (b), (c), 0, 0, 0)
template <bool OUT>
__device__ __forceinline__ void hgrn_unit(int unit, LAS unsigned char* lds, const float* HLF, const bf16* HQ, const bf16* HV, const bf16* HG, bf16* MIX, float* UBUF, float* DTOT, const float* SST) {
    const int tid = threadIdx.x, lane = tid & 63, wid = __builtin_amdgcn_readfirstlane(tid >> 6), r32 = lane & 31, hi = lane >> 5;
    const int bh = unit >> 5, sc = unit & 31, b = bh >> 2, h = bh & 3, col0 = h * 128;
    const int row_base = b * TP + sc * 256, kx = tid & 127, tq = tid >> 7;
    const int ki = wid & 3, vi0 = 2 * (wid >> 2);
    LAS bf16* QT = (LAS bf16*)(lds + H_QT); LAS bf16* KI = (LAS bf16*)(lds + H_KI); LAS bf16* KET = (LAS bf16*)(lds + H_KET); LAS bf16* VT = (LAS bf16*)(lds + H_VT);
    LAS bf16* ST = (LAS bf16*)(lds + H_ST); LAS bf16* PP = (LAS bf16*)(lds + H_P); LAS float* DEC = (LAS float*)(lds + H_DEC); LAS float* TOT = (LAS float*)(lds + H_TOT);
    LAS float* OS = (LAS float*)(lds + H_QT);
    f32x16 S[2];
#pragma unroll
    for (int j = 0; j < 2; ++j)
#pragma unroll
        for (int r = 0; r < 16; ++r) S[j][r] = OUT ? SST[(size_t)unit * 16384 + (32 * ki + crow(r, hi)) * 128 + 32 * (vi0 + j) + r32] : 0.f;
    float dacc = 0.f;
    for (int c = 0; c < 4; ++c) {
        const int rows = row_base + 64 * c + 16 * tq;
        float cs[16]; unsigned short vv[16], qq[16];
#pragma unroll
        for (int i = 0; i < 16; ++i) { cs[i] = HLF[(size_t)(rows + i) * 512 + col0 + kx]; vv[i] = HV[(size_t)(rows + i) * 512 + col0 + kx]; if (OUT) qq[i] = HQ[(size_t)(rows + i) * 512 + col0 + kx]; }
        float lf[16];
#pragma unroll
        for (int i = 0; i < 16; ++i) { lf[i] = cs[i]; if (i) cs[i] += cs[i - 1]; }
        TOT[tq * 128 + kx] = cs[15];
        LDS_SYNC();
        float off = 0.f, blast = 0.f;
#pragma unroll
        for (int q = 0; q < 4; ++q) { const float t = TOT[q * 128 + kx]; if (q < tq) off += t; blast += t; }
        unsigned kew[8], vtw[8];
#pragma unroll
        for (int i = 0; i < 16; i += 2) {
            float ke[2];
#pragma unroll
            for (int e = 0; e < 2; ++e) { const float bi = off + cs[i + e], kk = 1.0f - ex2(lf[i + e] * LOG2E_F); ke[e] = kk * ex2((blast - bi) * LOG2E_F);
                if (OUT) { QT[(16 * tq + i + e) * 136 + kx] = (bf16)f2bf(bf2f(qq[i + e]) * ex2(bi * LOG2E_F)); KI[(16 * tq + i + e) * 136 + kx] = (bf16)f2bf(kk * ex2(-bi * LOG2E_F)); } }
            kew[i >> 1] = pk2(ke[0], ke[1]); vtw[i >> 1] = (unsigned)vv[i] | ((unsigned)vv[i + 1] << 16);
        }
        *(LAS v4u*)(KET + kx * 72 + 16 * tq) = (v4u){kew[0], kew[1], kew[2], kew[3]}; *(LAS v4u*)(KET + kx * 72 + 16 * tq + 8) = (v4u){kew[4], kew[5], kew[6], kew[7]};
        *(LAS v4u*)(VT + kx * 72 + 16 * tq) = (v4u){vtw[0], vtw[1], vtw[2], vtw[3]}; *(LAS v4u*)(VT + kx * 72 + 16 * tq + 8) = (v4u){vtw[4], vtw[5], vtw[6], vtw[7]};
        if (tq == 0) { DEC[kx] = ex2(blast * LOG2E_F); dacc += blast; }
        if (OUT && c == 0) {
#pragma unroll
            for (int j = 0; j < 2; ++j)
#pragma unroll
                for (int g = 0; g < 4; ++g) *(LAS v2u*)(ST + (32 * (vi0 + j) + r32) * 136 + 32 * ki + 8 * g + 4 * hi) = (v2u){pk2(S[j][4 * g], S[j][4 * g + 1]), pk2(S[j][4 * g + 2], S[j][4 * g + 3])};
        }
        LDS_SYNC();
        f32x16 oacc;
        if (OUT) {
            if (wid < 3) {
                const int ti = wid > 0, si = wid == 2; f32x16 am;
#pragma unroll
                for (int r = 0; r < 16; ++r) am[r] = 0.f;
#pragma unroll
                for (int ks = 0; ks < 8; ++ks) { const bf16x8 a = *(const LAS bf16x8*)(QT + (32 * ti + r32) * 136 + 16 * ks + 8 * hi), bb = *(const LAS bf16x8*)(KI + (32 * si + r32) * 136 + 16 * ks + 8 * hi); am = MFMA32(a, bb, am); }
#pragma unroll
                for (int r = 0; r < 16; ++r) { const int t = 32 * ti + crow(r, hi), s = 32 * si + r32; PP[t * 72 + s] = (bf16)f2bf(s <= t ? am[r] : 0.f); }
            } else if (wid == 3) {
#pragma unroll
                for (int r = 0; r < 16; ++r) PP[crow(r, hi) * 72 + 32 + r32] = 0;
            }
            LDS_SYNC();
            const int ti = wid & 1, vi = wid >> 1;
#pragma unroll
            for (int r = 0; r < 16; ++r) oacc[r] = 0.f;
#pragma unroll
            for (int ks = 0; ks < 4; ++ks) { const bf16x8 a = *(const LAS bf16x8*)(PP + (32 * ti + r32) * 72 + 16 * ks + 8 * hi), bb = *(const LAS bf16x8*)(VT + (32 * vi + r32) * 72 + 16 * ks + 8 * hi); oacc = MFMA32(a, bb, oacc); }
#pragma unroll
            for (int ks = 0; ks < 8; ++ks) { const bf16x8 a = *(const LAS bf16x8*)(QT + (32 * ti + r32) * 136 + 16 * ks + 8 * hi), bb = *(const LAS bf16x8*)(ST + (32 * vi + r32) * 136 + 16 * ks + 8 * hi); oacc = MFMA32(a, bb, oacc); }
        }
        {
            float dk[16];
#pragma unroll
            for (int r = 0; r < 16; ++r) dk[r] = DEC[32 * ki + crow(r, hi)];
#pragma unroll
            for (int j = 0; j < 2; ++j)
#pragma unroll
                for (int r = 0; r < 16; ++r) S[j][r] *= dk[r];
#pragma unroll
            for (int ks = 0; ks < 4; ++ks) { const bf16x8 a = *(const LAS bf16x8*)(KET + (32 * ki + r32) * 72 + 16 * ks + 8 * hi);
#pragma unroll
                for (int j = 0; j < 2; ++j) { const bf16x8 bb = *(const LAS bf16x8*)(VT + (32 * (vi0 + j) + r32) * 72 + 16 * ks + 8 * hi); S[j] = MFMA32(a, bb, S[j]); } }
        }
        if (OUT) {
            LDS_SYNC();
            const int ti = wid & 1, vi = wid >> 1;
#pragma unroll
            for (int r = 0; r < 16; ++r) OS[(32 * ti + crow(r, hi)) * 132 + 32 * vi + r32] = oacc[r];
#pragma unroll
            for (int j = 0; j < 2; ++j)
#pragma unroll
                for (int g = 0; g < 4; ++g) *(LAS v2u*)(ST + (32 * (vi0 + j) + r32) * 136 + 32 * ki + 8 * g + 4 * hi) = (v2u){pk2(S[j][4 * g], S[j][4 * g + 1]), pk2(S[j][4 * g + 2], S[j][4 * g + 3])};
            LDS_SYNC();
            const int t = tid >> 3, seg = tid & 7; const int row = row_base + 64 * c + t;
            f32x4 o4[4]; float ss = 0.f;
#pragma unroll
            for (int i = 0; i < 4; ++i) { o4[i] = *(const LAS f32x4*)(OS + t * 132 + 16 * seg + 4 * i); ss += (o4[i][0] * o4[i][0] + o4[i][1] * o4[i][1]) + (o4[i][2] * o4[i][2] + o4[i][3] * o4[i][3]); }
            ss += __shfl_xor(ss, 1); ss += __shfl_xor(ss, 2); ss += __shfl_xor(ss, 4);
            const float rstd = rsqrtf(ss * (1.0f / 128.0f) + EPSF);
            const v4u g0 = *(const v4u*)(HG + (size_t)row * 512 + col0 + 16 * seg), g1 = *(const v4u*)(HG + (size_t)row * 512 + col0 + 16 * seg + 8);
            const unsigned gw[8] = {g0.x, g0.y, g0.z, g0.w, g1.x, g1.y, g1.z, g1.w}; unsigned ow[8];
#pragma unroll
            for (int i = 0; i < 8; ++i) { const float a = o4[i >> 1][2 * (i & 1)] * rstd * __builtin_bit_cast(float, gw[i] << 16), bq = o4[i >> 1][2 * (i & 1) + 1] * rstd * __builtin_bit_cast(float, gw[i] & 0xffff0000u); ow[i] = pk2(a, bq); }
            *(v4u*)(MIX + (size_t)row * 1024 + 512 + col0 + 16 * seg) = (v4u){ow[0], ow[1], ow[2], ow[3]}; *(v4u*)(MIX + (size_t)row * 1024 + 512 + col0 + 16 * seg + 8) = (v4u){ow[4], ow[5], ow[6], ow[7]};
        }
        LDS_SYNC();
    }
    if (!OUT) {
#pragma unroll
        for (int j = 0; j < 2; ++j)
#pragma unroll
            for (int r = 0; r < 16; ++r) UBUF[(size_t)unit * 16384 + (32 * ki + crow(r, hi)) * 128 + 32 * (vi0 + j) + r32] = S[j][r];
        if (tq == 0) DTOT[unit * 128 + kx] = ex2(dacc * LOG2E_F);
    }
}
__device__ __forceinline__ void hgrn_scan(int gtid, int gsize, const float* UBUF, const float* DTOT, float* SST, float* ohp) {
    for (int e = gtid; e < 8 * 16384; e += gsize) {
        const int bh = e >> 14, idx = e & 16383, k = idx >> 7; float s = 0.f;
#pragma unroll 8
        for (int sc = 0; sc < 32; ++sc) { const int unit = bh * 32 + sc; SST[(size_t)unit * 16384 + idx] = s; s = DTOT[unit * 128 + k] * s + UBUF[(size_t)unit * 16384 + idx]; }
        ohp[(size_t)bh * 16384 + idx] = s;
    }
}
__device__ __forceinline__ void hgrn_sample_unit(int unit, LAS unsigned char* lds, const float* sh, const float* HLF, const bf16* HQ, const bf16* HV, const bf16* HG, bf16* MIX, float* ohs) {
    const int tid = threadIdx.x, wid = tid >> 6, b = unit >> 2, h = unit & 3, v4 = tid & 31, kq = tid >> 5;
    LAS float* OP = (LAS float*)lds;
    LAS float* PS = (LAS float*)(lds + 32768);
    const float* s0 = sh + ((size_t)unit * 128 + 8 * kq) * 128 + 4 * v4;
    f32x4 S[8];
#pragma unroll
    for (int i = 0; i < 8; ++i) S[i] = *(const f32x4*)(s0 + i * 128);
#pragma unroll
    for (int t = 0; t < 4; ++t) {
        const size_t rb = (size_t)(MP + 4 * b + t) * 512 + h * 128;
        const v2u vw = *(const v2u*)(HV + rb + 4 * v4);
        const f32x4 vv = {__builtin_bit_cast(float, vw.x << 16), __builtin_bit_cast(float, vw.x & 0xffff0000u), __builtin_bit_cast(float, vw.y << 16), __builtin_bit_cast(float, vw.y & 0xffff0000u)};
        f32x4 po = {0.f, 0.f, 0.f, 0.f};
#pragma unroll
        for (int i = 0; i < 8; ++i) { const float f = ex2(HLF[rb + 8 * kq + i] * LOG2E_F), q = bf2f(HQ[rb + 8 * kq + i]); S[i] = S[i] * f + vv * (1.0f - f); po += S[i] * q; }
        *(LAS f32x4*)(OP + (t * 16 + kq) * 128 + 4 * v4) = po;
    }
    float* so = ohs + ((size_t)unit * 128 + 8 * kq) * 128 + 4 * v4;
#pragma unroll
    for (int i = 0; i < 8; ++i) *(f32x4*)(so + i * 128) = S[i];
    LDS_SYNC();
    const int t = tid >> 7, v = tid & 127; float o = 0.f;
#pragma unroll
    for (int q = 0; q < 16; ++q) o += OP[(t * 16 + q) * 128 + v];
    const float ps = wave_sum(o * o);
    if ((tid & 63) == 0) PS[wid] = ps;
    LDS_SYNC();
    const float rstd = rsqrtf((PS[2 * t] + PS[2 * t + 1]) * (1.0f / 128.0f) + EPSF);
    const size_t row = (size_t)(MP + 4 * b + t);
    MIX[row * 1024 + 512 + h * 128 + v] = (bf16)f2bf(o * rstd * bf2f(HG[row * 512 + h * 128 + v]));
    LDS_SYNC();
}

#ifdef DIAG_T9
__device__ __forceinline__ void hgrn_seq_unit(int bh, LAS unsigned char* lds, const float* HLF, const bf16* HQ, const bf16* HV, const bf16* HG, bf16* MIX) {
    const int tid = threadIdx.x, wid = tid >> 6, b = bh >> 2, h = bh & 3, v4 = tid & 31, kq = tid >> 5;
    LAS float* OP = (LAS float*)lds; LAS float* PS = (LAS float*)(lds + 32768);
    f32x4 S[8];
#pragma unroll
    for (int i = 0; i < 8; ++i) S[i] = (f32x4){0.f, 0.f, 0.f, 0.f};
    for (int g = 0; g < TP / 4; ++g) {
#pragma unroll
        for (int t = 0; t < 4; ++t) {
            const size_t rb = (size_t)(b * TP + 4 * g + t) * 512 + h * 128;
            const v2u vw = *(const v2u*)(HV + rb + 4 * v4);
            const f32x4 vv = {__builtin_bit_cast(float, vw.x << 16), __builtin_bit_cast(float, vw.x & 0xffff0000u), __builtin_bit_cast(float, vw.y << 16), __builtin_bit_cast(float, vw.y & 0xffff0000u)};
            f32x4 po = {0.f, 0.f, 0.f, 0.f};
#pragma unroll
            for (int i = 0; i < 8; ++i) { const float f = ex2(HLF[rb + 8 * kq + i] * LOG2E_F), q = bf2f(HQ[rb + 8 * kq + i]); S[i] = S[i] * f + vv * (1.0f - f); po += S[i] * q; }
            *(LAS f32x4*)(OP + (t * 16 + kq) * 128 + 4 * v4) = po;
        }
        LDS_SYNC();
        const int t = tid >> 7, v = tid & 127; float o = 0.f;
#pragma unroll
        for (int q = 0; q < 16; ++q) o += OP[(t * 16 + q) * 128 + v];
        const float ps = wave_sum(o * o);
        if ((tid & 63) == 0) PS[wid] = ps;
        LDS_SYNC();
        const float rstd = rsqrtf((PS[2 * t] + PS[2 * t + 1]) * (1.0f / 128.0f) + EPSF);
        const size_t row = (size_t)(b * TP + 4 * g + t);
        if (DIAG_SEL(4 * g + t)) MIX[row * 1024 + 512 + h * 128 + v] = (bf16)f2bf(o * rstd * bf2f(HG[row * 512 + h * 128 + v]));
        LDS_SYNC();
    }
}
#endif
namespace att {
constexpr int SLOT = 16384, NSLOT = 3, L_K = 0, L_V = NSLOT * SLOT, L_STG = 0, STG_BYTES = 17408;
static_assert(L_V + NSLOT * SLOT <= RING_BYTES && 4 * STG_BYTES <= L_V + NSLOT * SLOT, "attention LDS");
__device__ __forceinline__ void glds16(const void* gsrc, unsigned lds_dst) { unsigned keep;
    asm volatile("s_mov_b32 %0, m0\n\ts_mov_b32 m0, %2\n\ts_nop 0\n\tglobal_load_lds_dwordx4 %1, off\n\ts_mov_b32 m0, %0" : "=&s"(keep) : "v"(gsrc), "s"(lds_dst) : "memory"); }
__device__ __forceinline__ unsigned cvtpk_s(float lo, float hi) { return pg8::cvt_pk_bf16(lo, hi); }
__device__ __forceinline__ void attn_unit(int b, int h, int qb, const bf16* Q, const bf16* K, const bf16* V, bf16* MIX, LAS unsigned char* lds, const LAS float* BLh, float lam, LAS float* als) {
    const int tid = threadIdx.x, lane = tid & 63, r32 = lane & 31, hi = lane >> 5; const int wid = __builtin_amdgcn_readfirstlane(tid >> 6), map = wid >> 2, qw = wid & 3;
    const long rowbase = (long)b * TP; const int q0 = qb * 128;
    const bf16* Qw = Q + (rowbase + q0 + qw * 32) * 512 + h * 128 + map * 64;
    const bf16* Kh = K + rowbase * 512 + h * 128; const bf16* Vh = V + rowbase * 512 + h * 128;
    const unsigned lds0 = (unsigned)(uintptr_t)lds;
    const bf16* ksrc0 = Kh + (long)lane * 512 + (wid >> 3) * 64 + (wid & 7) * 8;
    const bf16* ksrc1 = Kh + (long)lane * 512 + 64 + (wid & 7) * 8;
    const bf16* vsrc0 = Vh + (long)(16 * (wid & 3) + (lane >> 2)) * 512 + (wid >> 2) * 32 + (lane & 3) * 8;
    const bf16* vsrc1 = Vh + (long)(16 * (wid & 3) + (lane >> 2)) * 512 + (2 + (wid >> 2)) * 32 + (lane & 3) * 8;
#define ADMA(t, slot) do { const long o_ = (long)(t) * 64 * 512; const unsigned s_ = (unsigned)(slot) * SLOT; \
        glds16(ksrc0 + o_, (unsigned)__builtin_amdgcn_readfirstlane(lds0 + L_K + s_ + wid * 1024)); glds16(ksrc1 + o_, (unsigned)__builtin_amdgcn_readfirstlane(lds0 + L_K + s_ + (wid + 8) * 1024)); \
        glds16(vsrc0 + o_, (unsigned)__builtin_amdgcn_readfirstlane(lds0 + L_V + s_ + wid * 1024)); glds16(vsrc1 + o_, (unsigned)__builtin_amdgcn_readfirstlane(lds0 + L_V + s_ + (wid + 8) * 1024)); } while (0)
    const int NT = 2 * qb + 2;
    bf16x8 qr[4];
#pragma unroll
    for (int d0 = 0; d0 < 4; ++d0) qr[d0] = *(const bf16x8*)(Qw + (long)r32 * 512 + d0 * 16 + hi * 8);
    asm volatile("s_waitcnt vmcnt(0)" ::: "memory");
    ADMA(0, 0); ADMA(1, 1);
    f32x16 o[4];
#pragma unroll
    for (int d = 0; d < 4; ++d)
#pragma unroll
        for (int r = 0; r < 16; ++r) o[d][r] = 0.f;
    float lsum = 0.f;
    const float cfar = BLh[127];
    const int qabs = q0 + qw * 32 + r32;
    int slot = 0;
    for (int t = 0; t < NT; ++t) {
        if (t + 1 < NT) asm volatile("s_waitcnt vmcnt(4) lgkmcnt(0)\n\ts_barrier" ::: "memory"); else asm volatile("s_waitcnt vmcnt(0) lgkmcnt(0)\n\ts_barrier" ::: "memory");
        if (t + 2 < NT) { const int s2 = slot == 0 ? 2 : slot - 1; ADMA(t + 2, s2); }
        const LAS unsigned char* kb = lds + L_K + slot * SLOT + map * 8192 + hi * 1024 + r32 * 16;
        const bool band = t >= NT - 4;
        f32x16 p0, p1; const float ci = band ? 0.f : cfar;
#pragma unroll
        for (int r = 0; r < 16; ++r) { p0[r] = ci; p1[r] = ci; }
#pragma unroll
        for (int d0 = 0; d0 < 4; ++d0) { const bf16x8 b0 = *(const LAS bf16x8*)(kb + d0 * 2048), b1 = *(const LAS bf16x8*)(kb + d0 * 2048 + 512); p0 = MFMA32(b0, qr[d0], p0); p1 = MFMA32(b1, qr[d0], p1); }
        if (band) {
            const int kbase = 64 * t + 4 * hi;
#pragma unroll
            for (int r = 0; r < 16; ++r) { const int kv = kbase + (r & 3) + 8 * (r >> 2); const int n0 = qabs - kv, n1 = n0 - 32;
                p0[r] = n0 < 0 ? -INFINITY : p0[r] + BLh[n0 > 127 ? 127 : (n0 < 0 ? 0 : n0)]; p1[r] = n1 < 0 ? -INFINITY : p1[r] + BLh[n1 > 127 ? 127 : (n1 < 0 ? 0 : n1)]; }
        }
        float sacc = 0.f;
#pragma unroll
        for (int r = 0; r < 16; ++r) { p0[r] = ex2(p0[r]); p1[r] = ex2(p1[r]); sacc += p0[r] + p1[r]; }
        lsum += sacc;
        bf16x8 pa[4];
        { v4u w;
          w = (v4u){cvtpk_s(p0[0], p0[1]), cvtpk_s(p0[2], p0[3]), cvtpk_s(p0[4], p0[5]), cvtpk_s(p0[6], p0[7])}; pa[0] = __builtin_bit_cast(bf16x8, w);
          w = (v4u){cvtpk_s(p0[8], p0[9]), cvtpk_s(p0[10], p0[11]), cvtpk_s(p0[12], p0[13]), cvtpk_s(p0[14], p0[15])}; pa[1] = __builtin_bit_cast(bf16x8, w);
          w = (v4u){cvtpk_s(p1[0], p1[1]), cvtpk_s(p1[2], p1[3]), cvtpk_s(p1[4], p1[5]), cvtpk_s(p1[6], p1[7])}; pa[2] = __builtin_bit_cast(bf16x8, w);
          w = (v4u){cvtpk_s(p1[8], p1[9]), cvtpk_s(p1[10], p1[11]), cvtpk_s(p1[12], p1[13]), cvtpk_s(p1[14], p1[15])}; pa[3] = __builtin_bit_cast(bf16x8, w); }
        const int vb = (int)(lds0 + L_V + slot * SLOT) + ((lane >> 4) & 1) * 32 + (lane & 3) * 8 + (4 * hi + ((lane & 15) >> 2)) * 64;
#pragma unroll
        for (int d0 = 0; d0 < 4; ++d0) { s16x4 lo[4], hh[4];
#pragma unroll
            for (int ks = 0; ks < 4; ++ks) {
                asm volatile("ds_read_b64_tr_b16 %0,%1 offset:%c2" : "=&v"(lo[ks]) : "v"(vb), "i"(d0 * 4096 + ks * 1024) : "memory");
                asm volatile("ds_read_b64_tr_b16 %0,%1 offset:%c2" : "=&v"(hh[ks]) : "v"(vb), "i"(d0 * 4096 + ks * 1024 + 512) : "memory"); }
            asm volatile("s_waitcnt lgkmcnt(0)" ::: "memory"); __builtin_amdgcn_sched_barrier(0);
#pragma unroll
            for (int ks = 0; ks < 4; ++ks) { const bf16x8 vf = (bf16x8){lo[ks][0], lo[ks][1], lo[ks][2], lo[ks][3], hh[ks][0], hh[ks][1], hh[ks][2], hh[ks][3]}; o[d0] = MFMA32(pa[ks], vf, o[d0]); }
        }
        slot = slot == 2 ? 0 : slot + 1;
    }
#undef ADMA
    { auto rr = __builtin_amdgcn_permlane32_swap(__float_as_uint(lsum), __float_as_uint(lsum), false, false); lsum = __uint_as_float(rr[0]) + __uint_as_float(rr[1]); }
    LAS float* myl = als + wid * 32;
    if (hi == 0) myl[r32] = lsum;
    asm volatile("s_waitcnt vmcnt(0) lgkmcnt(0)\n\ts_barrier" ::: "memory");
    float rl[16];
#pragma unroll
    for (int r = 0; r < 16; ++r) rl[r] = __builtin_amdgcn_rcpf(myl[crow(r, hi)]);
    LAS float* stg = (LAS float*)(lds + L_STG + qw * STG_BYTES);
    if (map == 1) {
#pragma unroll
        for (int d = 0; d < 4; ++d)
#pragma unroll
            for (int r = 0; r < 16; ++r) stg[(d * 16 + r) * 64 + lane] = o[d][r] * rl[r];
    }
    asm volatile("s_waitcnt lgkmcnt(0)\n\ts_barrier" ::: "memory");
    if (map == 0) {
#pragma unroll
        for (int d = 0; d < 4; ++d)
#pragma unroll
            for (int r = 0; r < 16; ++r) o[d][r] = o[d][r] * rl[r] - lam * stg[(d * 16 + r) * 64 + lane];
        asm volatile("s_waitcnt lgkmcnt(0)" ::: "memory");
#pragma unroll
        for (int d = 0; d < 4; ++d)
#pragma unroll
            for (int r = 0; r < 16; ++r) stg[crow(r, hi) * 132 + d * 32 + r32] = o[d][r];
        asm volatile("s_waitcnt lgkmcnt(0)" ::: "memory");
        bf16* Mw = MIX + (rowbase + q0 + qw * 32) * 1024 + h * 128;
#pragma unroll
        for (int ps = 0; ps < 8; ++ps) { const int row = ps * 4 + (lane >> 4), seg = lane & 15;
            const f32x4 a = *(const LAS f32x4*)(stg + row * 132 + 8 * seg), c = *(const LAS f32x4*)(stg + row * 132 + 8 * seg + 4);
            float ss = (a[0] * a[0] + a[1] * a[1]) + (a[2] * a[2] + a[3] * a[3]) + (c[0] * c[0] + c[1] * c[1]) + (c[2] * c[2] + c[3] * c[3]);
            ss += __shfl_xor(ss, 1); ss += __shfl_xor(ss, 2); ss += __shfl_xor(ss, 4); ss += __shfl_xor(ss, 8);
            const float rstd = rsqrtf(ss * (1.0f / 128.0f) + EPSF);
            *(v4u*)(Mw + (long)row * 1024 + 8 * seg) = (v4u){cvtpk_s(a[0] * rstd, a[1] * rstd), cvtpk_s(a[2] * rstd, a[3] * rstd), cvtpk_s(c[0] * rstd, c[1] * rstd), cvtpk_s(c[2] * rstd, c[3] * rstd)}; }
    }
    asm volatile("s_waitcnt lgkmcnt(0)\n\ts_barrier" ::: "memory");
}
}
namespace dec {
typedef float f32x4 __attribute__((ext_vector_type(4)));
#define MFMA16(a, b, c) __builtin_amdgcn_mfma_f32_16x16x32_bf16((a), (b), (c), 0, 0, 0)
__device__ __forceinline__ bf16x8 cvt8(f32x4 a, f32x4 b) { v4u w = {pk2(a[0], a[1]), pk2(a[2], a[3]), pk2(b[0], b[1]), pk2(b[2], b[3])}; return __builtin_bit_cast(bf16x8, w); }
__device__ __forceinline__ void decode_unit(int b, const float* ck, const float* cv, const int* pt, const bf16* QB, const float* ksamp, const float* vsamp, bf16* MIX, LAS unsigned char* lds, const LAS float* BL, float lam) {
    const int tid = threadIdx.x, lane = tid & 63, n = lane & 15, q = lane >> 4; const int wid = __builtin_amdgcn_readfirstlane(tid >> 6), h = wid & 3, kh = wid >> 2;
    const LAS float* BLh = BL + h * 128;
    bf16x8 qf[2][2];
#pragma unroll
    for (int mp = 0; mp < 2; ++mp)
#pragma unroll
        for (int ks = 0; ks < 2; ++ks) { const int tok = n - 4 * mp; const bool ok = tok >= 0 && tok < 4;
            const v4u w = ok ? *(const v4u*)(QB + (size_t)(MP + 4 * b + tok) * 512 + h * 128 + mp * 64 + 32 * ks + 8 * q) : (v4u){0u, 0u, 0u, 0u}; qf[mp][ks] = __builtin_bit_cast(bf16x8, w); }
    const int tok = n & 3;
    f32x4 O[8];
#pragma unroll
    for (int c = 0; c < 8; ++c) O[c] = (f32x4){0.f, 0.f, 0.f, 0.f};
    float lsum = 0.f;
    const int NIT = kh == 0 ? 33 : 32;
    for (int i = 0; i < NIT; ++i) {
        const bool isnew = i == 32;
        const int T = 2 * i + kh;
        const float* kbase; const float* vbase; int key0;
        if (!isnew) { const int phys = pt[b * NPAGES + (T >> 2)]; const size_t ro = ((size_t)phys * PAGE + 32 * (T & 3)) * 512 + h * 128; kbase = ck + ro; vbase = cv + ro; key0 = 32 * T; }
        else { const size_t ro = (size_t)(4 * b) * 512 + h * 128; kbase = ksamp + ro; vbase = vsamp + ro; key0 = PAST; }
        f32x4 s[2];
#pragma unroll
        for (int sub = 0; sub < 2; ++sub) {
            s[sub] = (f32x4){0.f, 0.f, 0.f, 0.f};
            if (isnew && sub == 1) continue;
            int key = 16 * sub + n; if (isnew) key = key > 3 ? 3 : key;
            const float* kp = kbase + (size_t)key * 512 + 8 * q;
#pragma unroll
            for (int mp = 0; mp < 2; ++mp)
#pragma unroll
                for (int ks = 0; ks < 2; ++ks) { const f32x4 a0 = *(const f32x4*)(kp + mp * 64 + 32 * ks), a1 = *(const f32x4*)(kp + mp * 64 + 32 * ks + 4); s[sub] = MFMA16(cvt8(a0, a1), qf[mp][ks], s[sub]); }
        }
        f32x4 p[2];
#pragma unroll
        for (int sub = 0; sub < 2; ++sub)
#pragma unroll
            for (int r = 0; r < 4; ++r) { const int kl = 16 * sub + 4 * q + r; const int dist = PAST + tok - (key0 + kl);
                bool ok = n < 8; if (isnew) ok = ok && kl < 4 && dist >= 0;
                const int di = dist > 127 ? 127 : (dist < 0 ? 0 : dist);
                p[sub][r] = ok ? ex2(s[sub][r] + BLh[di]) : 0.f; }
        lsum += ((p[0][0] + p[0][1]) + (p[0][2] + p[0][3])) + ((p[1][0] + p[1][1]) + (p[1][2] + p[1][3]));
        const bf16x8 pf = cvt8(p[0], p[1]);
        f32x4 vr[8][2];
#pragma unroll
        for (int j = 0; j < 8; ++j) { int key = (j < 4) ? 4 * q + j : 16 + 4 * q + (j - 4); if (isnew) key = key > 3 ? 3 : key;
#pragma unroll
            for (int hf = 0; hf < 2; ++hf) vr[j][hf] = *(const f32x4*)(vbase + (size_t)key * 512 + 64 * hf + 4 * n); }
#pragma unroll
        for (int hf = 0; hf < 2; ++hf)
#pragma unroll
            for (int c = 0; c < 4; ++c) { const v4u w = {pk2(vr[0][hf][c], vr[1][hf][c]), pk2(vr[2][hf][c], vr[3][hf][c]), pk2(vr[4][hf][c], vr[5][hf][c]), pk2(vr[6][hf][c], vr[7][hf][c])};
                O[hf * 4 + c] = MFMA16(pf, __builtin_bit_cast(bf16x8, w), O[hf * 4 + c]); }
    }
    lsum += __shfl_xor(lsum, 16); lsum += __shfl_xor(lsum, 32);
    LAS float* cb = (LAS float*)lds + h * (33 * 64);
    if (kh == 1) {
#pragma unroll
        for (int c = 0; c < 8; ++c)
#pragma unroll
            for (int r = 0; r < 4; ++r) cb[(c * 4 + r) * 64 + lane] = O[c][r];
        cb[32 * 64 + lane] = lsum;
    }
    LDS_SYNC();
    if (kh == 0) {
#pragma unroll
        for (int c = 0; c < 8; ++c)
#pragma unroll
            for (int r = 0; r < 4; ++r) O[c][r] += cb[(c * 4 + r) * 64 + lane];
        lsum += cb[32 * 64 + lane];
        LAS float* ls = (LAS float*)lds + 4 * 33 * 64 + h * 16;
        if (q == 0) ls[n] = lsum;
        asm volatile("s_waitcnt lgkmcnt(0)" ::: "memory");
        float y[8][4], ss[4] = {0.f, 0.f, 0.f, 0.f};
#pragma unroll
        for (int r = 0; r < 4; ++r) { const float rl0 = __builtin_amdgcn_rcpf(ls[r]), rl1 = __builtin_amdgcn_rcpf(ls[4 + r]);
#pragma unroll
            for (int c = 0; c < 8; ++c) { const float o1 = __shfl(O[c][r], (lane & 15) + 16); y[c][r] = O[c][r] * rl0 - lam * o1 * rl1; ss[r] += y[c][r] * y[c][r]; } }
#pragma unroll
        for (int r = 0; r < 4; ++r) { ss[r] += __shfl_xor(ss[r], 1); ss[r] += __shfl_xor(ss[r], 2); ss[r] += __shfl_xor(ss[r], 4); ss[r] += __shfl_xor(ss[r], 8); }
        if (q == 0) {
#pragma unroll
            for (int r = 0; r < 4; ++r) { const float rstd = rsqrtf(ss[r] * (1.0f / 128.0f) + EPSF); bf16* mo = MIX + (size_t)(MP + 4 * b + r) * 1024 + h * 128 + 4 * n;
#pragma unroll
                for (int hf = 0; hf < 2; ++hf) *(v2u*)(mo + 64 * hf) = (v2u){pk2(y[hf * 4][r] * rstd, y[hf * 4 + 1][r] * rstd), pk2(y[hf * 4 + 2][r] * rstd, y[hf * 4 + 3][r] * rstd)}; }
        }
    }
    LDS_SYNC();
}
}
struct Args { PIn in; float* out; unsigned char* ws; };
typedef __attribute__((address_space(4))) const Args* KArgs;
__device__ __forceinline__ void p0_prologue(KArgs A, unsigned char* ws, LAS unsigned char* lds, int vcu, int G, int wave, int lane) {
    LAS float* scr = (LAS float*)(lds + RING_OFF + wave * 16384);
    const int gw = vcu * NWAVES + wave, NGW = G * NWAVES;
    bf16* WIN = (bf16*)(ws + WS_WIN); bf16* WOUT = (bf16*)(ws + WS_WOUT); bf16* WGU = (bf16*)(ws + WS_WGU); bf16* WDN = (bf16*)(ws + WS_WDN);
    constexpr int I_IN = 16 * 112, I_OUT = 16 * 32, I_G = 16 * 88, I_D = 44 * 32, NITEMS = I_IN + I_OUT + 2 * I_G + I_D;
    for (int it = gw; it < NITEMS; it += NGW) {
        int r = it;
        if (r < I_IN) { const int kb = r / 112, nb = r % 112, pn = nb >> 3, cbk = nb & 7; const float* g1 = A->in.g1;
            p0_transpose_item(A->in.win, DM, NIN, WIN, kb, nb, 256 * pn + 128 * (cbk & 1) + 32 * (cbk >> 1), scr, lane, [g1](int k) { return g1[k]; }); continue; } r -= I_IN;
        if (r < I_OUT) { const int kb = r / 32, nb = r % 32; const float* sg = A->in.subg; const float* og = A->in.ong;
            p0_transpose_item(A->in.wout, DM, DM, WOUT, kb, nb, 32 * nb, scr, lane, [sg, og](int k) { return k < 512 ? 0.8f * sg[k & 127] : og[k & 127]; }); continue; } r -= I_OUT;
        if (r < I_G) { const int kb = r / 88, nb = r % 88; const float* g2 = A->in.g2;
            p0_transpose_item(A->in.wg, DM, DFF, WGU, kb, nb, 256 * (nb >> 2) + 32 * (nb & 3), scr, lane, [g2](int k) { return g2[k]; }); continue; } r -= I_G;
        if (r < I_G) { const int kb = r / 88, nb = r % 88; const float* g2 = A->in.g2;
            p0_transpose_item(A->in.wu, DM, DFF, WGU, kb, nb, 256 * (nb >> 2) + 128 + 32 * (nb & 3), scr, lane, [g2](int k) { return g2[k]; }); continue; } r -= I_G;
        { const int kb = r / 32, nb = r % 32; p0_transpose_item(A->in.wd, DFF, DM, WDN, kb, nb, 32 * nb, scr, lane, [](int) { return 1.0f; }); }
    }
    bf16* XB = (bf16*)(ws + WS_XB); float* RSTD1 = (float*)(ws + WS_RSTD1);
    for (int m = gw; m < MALL; m += NGW) {
        const float* xrow = m < MP ? A->in.xp + (size_t)m * DM : A->in.xs + (size_t)(m - MP) * DM;
        const GAS f32x4* xr = (const GAS f32x4*)xrow + lane; f32x4 v[4]; float s = 0.f;
#pragma unroll
        for (int j = 0; j < 4; ++j) { v[j] = xr[64 * j]; s += (v[j][0] * v[j][0] + v[j][1] * v[j][1]) + (v[j][2] * v[j][2] + v[j][3] * v[j][3]); }
        s = wave_sum(s);
        GAS v2u* o8 = (GAS v2u*)(XB + (size_t)m * DM) + lane;
#pragma unroll
        for (int j = 0; j < 4; ++j) o8[64 * j] = (v2u){pk2(v[j][0], v[j][1]), pk2(v[j][2], v[j][3])};
        if (lane == 0) RSTD1[m] = rsqrtf(s * (1.0f / DM) + EPSF);
    }
}
__device__ __forceinline__ void conv_fixup(int pm, const float* cwp, const float* cbp, unsigned char* ws, int tid) {
    const float* HA = (const float*)(ws + WS_HALOA); const float* HU = (const float*)(ws + WS_HALOU); const float* LA = (const float*)(ws + WS_LASTA); bf16* G = (bf16*)(ws + WS_G);
    const bool first = (pm & 31) == 0;
    for (int e = tid; e < 2 * DFF; e += NWAVES * 64) {
        const int i = e >= DFF, c = e - i * DFF;
        const float a = HA[(size_t)(pm * 2 + i) * DFF + c], u = HU[(size_t)(pm * 2 + i) * DFF + c];
        float p1, p2;
        if (i == 0) { p1 = first ? 0.f : LA[(size_t)((pm - 1) * 2 + 1) * DFF + c]; p2 = first ? 0.f : LA[(size_t)((pm - 1) * 2) * DFF + c]; }
        else { p1 = HA[(size_t)(pm * 2) * DFF + c]; p2 = first ? 0.f : LA[(size_t)((pm - 1) * 2 + 1) * DFF + c]; }
        const float cc = cbp[c] + cwp[c] * p2 + cwp[DFF + c] * p1 + cwp[2 * DFF + c] * a;
        G[(size_t)(pm * 256 + i) * DFF + c] = (bf16)f2bf(cc * sigm_f(cc) * u);
    }
}
__device__ __forceinline__ KArgs kargs() { KArgs p = (KArgs)__builtin_amdgcn_kernarg_segment_ptr(); asm volatile("" : "+s"(p)); return p; }
__global__ void __launch_bounds__(NWAVES * 64, 2) fwd(Args args_unused) {
    extern __shared__ __attribute__((aligned(16))) unsigned char lds_raw[];
    LAS unsigned char* lds = (LAS unsigned char*)lds_raw;
    const int tid = threadIdx.x, lane = tid & 63, wave = __builtin_amdgcn_readfirstlane(tid >> 6);
    const int G = gridDim.x, bx = blockIdx.x, vcu = (G % 8 == 0) ? (bx % 8) * (G / 8) + bx / 8 : bx;
    for (int u = tid; u < (LDS_BYTES - LDSCTL_OFF) / 4; u += NWAVES * 64) ((LAS unsigned*)(lds + LDSCTL_OFF))[u] = 0u;
    __syncthreads();
    volatile LAS unsigned* MISC = (volatile LAS unsigned*)(lds + MISC_OFF);
    XcdBarrier bar;
    { KArgs A = kargs(); bar = xcd_barrier_post((unsigned*)(A->ws + WS_CTL) + CW_BAR, MISC + 8); }
    LAS float* BL = (LAS float*)(lds + BL_OFF); LAS float* SCAL = (LAS float*)(lds + SCAL_OFF);
    { KArgs A = kargs(); const float* relb = A->in.relb; const float* lqk = A->in.lqk;
      const int h = tid >> 7, n = tid & 127; int bk = n;
      if (n >= 16) { bk = 16 + (int)(logf((float)n * (1.0f / 16.0f)) / logf(8.0f) * 16.0f); bk = bk > 31 ? 31 : bk; }
      BL[h * 128 + n] = relb[bk * 4 + h] * LOG2E_F;
      if (tid < 64) { float a = lqk[tid] * lqk[64 + tid], c = lqk[128 + tid] * lqk[192 + tid]; a = wave_sum(a); c = wave_sum(c); if (tid == 0) SCAL[0] = expf(a) - expf(c) + 0.2f; } }
    __syncthreads();

    { KArgs A = kargs(); p0_prologue(A, A->ws, lds, vcu, G, wave, lane); }
    xcd_barrier(bar);
    { KArgs A = kargs(); unsigned char* ws = A->ws; float* out = A->out;
      pg8::Gemm g{(const bf16*)(ws + WS_XB), (const bf16*)(ws + WS_WIN), MALL, NIN, DM}; pg8::StaticOrder S; S.init(MALL, NIN, G, bx);
      pg8::EpiIn E{(bf16*)(ws + WS_QB), (float*)(ws + WS_HLF), out + O_KP, out + O_KS, (const float*)(ws + WS_RSTD1), A->in.gqk, A->in.hlb};
      pg8::gemm_phase<pg8::EpiIn, pg8::StaticOrder, PG8_ALIGN, PG8_SP2>(lds + RING_OFF, g, S, E); }
    xcd_barrier(bar);
    { KArgs A = kargs(); unsigned char* ws = A->ws;
      for (int u = vcu; u < 256; u += G) hgrn_unit<false>(u, lds, (const float*)(ws + WS_HLF), (const bf16*)(ws + WS_HQ), (const bf16*)(ws + WS_HV), (const bf16*)(ws + WS_HG), (bf16*)(ws + WS_MIX), (float*)(ws + WS_UBUF), (float*)(ws + WS_DTOT), (const float*)(ws + WS_SST)); }
    xcd_barrier(bar);
    { KArgs A = kargs(); unsigned char* ws = A->ws;
      hgrn_scan(vcu * (NWAVES * 64) + tid, G * NWAVES * 64, (const float*)(ws + WS_UBUF), (const float*)(ws + WS_DTOT), (float*)(ws + WS_SST), A->out + O_HP); }
    xcd_barrier(bar);
    { KArgs A = kargs(); unsigned char* ws = A->ws;
      for (int u = vcu; u < 256; u += G) hgrn_unit<true>(u, lds, (const float*)(ws + WS_HLF), (const bf16*)(ws + WS_HQ), (const bf16*)(ws + WS_HV), (const bf16*)(ws + WS_HG), (bf16*)(ws + WS_MIX), (float*)(ws + WS_UBUF), (float*)(ws + WS_DTOT), (const float*)(ws + WS_SST)); }
#ifdef DIAG_T9
    { KArgs A = kargs(); unsigned char* ws = A->ws;
      for (int u = vcu; u < 8; u += G) hgrn_seq_unit(u, lds, (const float*)(ws + WS_HLF), (const bf16*)(ws + WS_HQ), (const bf16*)(ws + WS_HV), (const bf16*)(ws + WS_HG), (bf16*)(ws + WS_MIX)); }
#endif
    { KArgs A = kargs(); unsigned char* ws = A->ws;
      for (int u = vcu; u < NBS * 4; u += G) hgrn_sample_unit(u, lds, A->in.sh, (const float*)(ws + WS_HLF), (const bf16*)(ws + WS_HQ), (const bf16*)(ws + WS_HV), (const bf16*)(ws + WS_HG), (bf16*)(ws + WS_MIX), A->out + O_HS); }
    { KArgs A = kargs(); unsigned char* ws = A->ws; const float lam = SCAL[0];
      for (int b = vcu; b < NBS; b += G) dec::decode_unit(b, A->in.ck, A->in.cv, A->in.pt, (const bf16*)(ws + WS_QB), A->out + O_KS, A->out + O_VS, (bf16*)(ws + WS_MIX), lds, BL, lam); }
    { KArgs A = kargs(); unsigned char* ws = A->ws; const float lam = SCAL[0];
      const bf16* QB = (const bf16*)(ws + WS_QB); const bf16* KB = (const bf16*)(ws + WS_KB); const bf16* VB = (const bf16*)(ws + WS_VB); bf16* MIX = (bf16*)(ws + WS_MIX);
      for (int pi = vcu; pi < 256; pi += G) { const int bh = pi >> 5, s = pi & 31;
        att::attn_unit(bh >> 2, bh & 3, 63 - s, QB, KB, VB, MIX, lds, BL + (bh & 3) * 128, lam, (LAS float*)(lds + ALS_OFF));
        att::attn_unit(bh >> 2, bh & 3, s, QB, KB, VB, MIX, lds, BL + (bh & 3) * 128, lam, (LAS float*)(lds + ALS_OFF)); } }
    xcd_barrier(bar);
    { KArgs A = kargs(); unsigned char* ws = A->ws; float* out = A->out;
      pg8::Gemm g{(const bf16*)(ws + WS_MIX), (const bf16*)(ws + WS_WOUT), MALL, DM, DM}; pg8::StaticOrder S; S.init(MALL, DM, G, bx);
      pg8::EpiOut E{A->in.xp, A->in.xs, out + O_YP, out + O_YS, (bf16*)(ws + WS_X1B), (float*)(ws + WS_SSQP)};
      pg8::gemm_phase<pg8::EpiOut, pg8::StaticOrder, PG8_ALIGN, PG8_SP2>(lds + RING_OFF, g, S, E); }
    xcd_barrier(bar);
    { KArgs A = kargs(); unsigned char* ws = A->ws; float* out = A->out;
      pg8::Gemm g{(const bf16*)(ws + WS_X1B), (const bf16*)(ws + WS_WGU), MALL, 2 * DFF, DM}; pg8::StaticOrder S; S.init(MALL, 2 * DFF, G, bx);
      pg8::EpiGU E{(bf16*)(ws + WS_G), (const float*)(ws + WS_SSQP), A->in.cw, A->in.cb, A->in.sconv, (float*)(ws + WS_HALOA), (float*)(ws + WS_HALOU), (float*)(ws + WS_LASTA), out + O_CP, out + O_CS, (PG8_LAS float*)(lds + XCH_OFF)};
      pg8::gemm_phase<pg8::EpiGU, pg8::StaticOrder, true, PG8_SP2>(lds + RING_OFF, g, S, E); }
    xcd_barrier(bar);
    { KArgs A = kargs(); unsigned char* ws = A->ws; float* out = A->out;
      pg8::Gemm g{(const bf16*)(ws + WS_G), (const bf16*)(ws + WS_WDN), MALL, DM, DFF}; pg8::StaticOrder S; S.init(MALL, DM, G, bx);
      { const float* cwp = A->in.cw; const float* cbp = A->in.cb; pg8::Unit u; for (int i = 0; S.next(i, u); ++i) if (u.pm < 64) {
#ifndef DIAG_T2
        conv_fixup(u.pm, cwp, cbp, ws, tid);
#endif
      } }
      asm volatile("s_waitcnt vmcnt(0)" ::: "memory"); __syncthreads();
      pg8::EpiDown E{out + O_YP, out + O_YS};
      pg8::gemm_phase<pg8::EpiDown, pg8::StaticOrder, PG8_ALIGN, PG8_SP2>(lds + RING_OFF, g, S, E); }
}

extern "C" void kernel_launch(void* const* d_in, const int* in_sizes, int n_in, void* d_out, int out_size, void* d_ws, size_t ws_size, hipStream_t stream) {
    static int grid = 0;
    if (grid == 0) {
        if (n_in != 22 || out_size != (int)O_END || ws_size < WS_END) { fprintf(stderr, "kernel_launch: unexpected shapes: n_in %d out %d ws %zu\n", n_in, out_size, ws_size); grid = -1; return; }
        int dev = 0, cus = 0, per_cu = 0;
        if (hipGetDevice(&dev) != hipSuccess || hipDeviceGetAttribute(&cus, hipDeviceAttributeMultiprocessorCount, dev) != hipSuccess) { grid = -1; return; }
        if (hipFuncSetAttribute((const void*)fwd, hipFuncAttributeMaxDynamicSharedMemorySize, LDS_BYTES) != hipSuccess) { fprintf(stderr, "kernel_launch: hipFuncSetAttribute failed\n"); grid = -1; return; }
        if (hipOccupancyMaxActiveBlocksPerMultiprocessor(&per_cu, (const void*)fwd, NWAVES * 64, LDS_BYTES) != hipSuccess || per_cu < 1) fprintf(stderr, "kernel_launch: occupancy query says %d\n", per_cu);
        (void)hipGetLastError();
        grid = cus;
    }
    if (grid < 0) return;
    if (hipMemsetAsync((char*)d_ws + WS_CTL, 0, CTL_ZERO_BYTES, stream) != hipSuccess) return;
    Args a{};
    const void** pp = (const void**)&a.in;
    for (int i = 0; i < 22; ++i) pp[i] = d_in[i];
    a.out = (float*)d_out; a.ws = (unsigned char*)d_ws;
    hipLaunchKernelGGL(fwd, dim3(grid), dim3(NWAVES * 64), LDS_BYTES, stream, a);
}
```

```cpp
#include <hip/hip_runtime.h>
#include <hip/hip_bf16.h>
#include <cstdio>
#include <cstdint>
#include <cmath>
namespace pg8 {
#define PG8_LAS __attribute__((address_space(3)))
typedef unsigned short bf16_t;
typedef short bf16x8 __attribute__((ext_vector_type(8)));
typedef float f32x4 __attribute__((ext_vector_type(4)));
typedef unsigned u32x4 __attribute__((ext_vector_type(4)));
constexpr int BM = 256, BK = 64, HALF = 128, HTB = HALF * BK * 2  , STAGE_BYTES = 8 * HTB, NXCD = 8, WGM = 8;

__host__ __device__ __forceinline__ int lds_byte(int r, int c) { const int st = (r >> 4) * 2 + (c >> 5), rr = r & 15, cc = c & 31, ob = rr * 64 + cc * 2; return st * 1024 + (ob ^ (((ob >> 9) & 1) << 5)); }
__host__ __device__ __forceinline__ void stage_rc(int b, int& R, int& C) { const int st = b / 1024, sb = b % 1024, swz = sb ^ (((sb >> 9) & 1) << 5); R = (st >> 1) * 16 + swz / 64; C = (st & 1) * 32 + (swz % 64) / 2; }
__host__ __device__ __forceinline__ int perm32(int rho) { const int n = rho >> 4, i = rho & 15; return 8 * (i >> 2) + 4 * n + (i & 3); }

struct Unit { int pm, pn, kb, nt; };
struct Gemm { const bf16_t* A; const bf16_t* Bt; int M, N, K, ldk; };

struct StaticOrder {
    int nM, nN, nwg, G, c;
    __host__ __device__ void init(int M, int N, int G_, int c_) { nM = M / BM; nN = N / BM; nwg = nM * nN; G = G_; c = c_; }
    __host__ __device__ bool next(int i, Unit& u) const {
        const long L = (long)i * G + c; if (L >= nwg) return false;
        int wgid = (int)L; { const int q = nwg / NXCD, r = nwg % NXCD, xcd = wgid % NXCD, off = wgid / NXCD; wgid = (xcd < r ? xcd * (q + 1) : r * (q + 1) + (xcd - r) * q) + off; }
        const int nig = WGM * nN, gid = wgid / nig, fm = gid * WGM, gsz = (nM - fm) < WGM ? (nM - fm) : WGM;
        u.pm = fm + ((wgid % nig) % gsz); u.pn = (wgid % nig) / gsz; u.kb = 0; u.nt = 0; return true;
    }
    __device__ __forceinline__ void a_ready(const Unit&) const {}
    __device__ __forceinline__ void done(const Unit&) const {}
};


struct DownOrder {
    StaticOrder S0; int c, nsplit, klen;
    __device__ bool next(int i, Unit& u) const { const bool hp = c < 8 * nsplit;
        if (hp && i == 0) { const int tile = c % 8, p = c / 8; u.pm = 64 + (tile >> 2); u.pn = tile & 3; u.kb = p * klen * 2; u.nt = klen / BK; return true; }
        if (i == (hp ? 1 : 0)) return S0.next(0, u);
        return false; }
    __device__ __forceinline__ void a_ready(const Unit&) const {}
    __device__ __forceinline__ void done(const Unit&) const {}
};
typedef float f32x2_t __attribute__((ext_vector_type(2))); typedef __bf16 bf16x2_t __attribute__((ext_vector_type(2)));
__device__ __forceinline__ unsigned cvt_pk_bf16(float lo, float hi) { f32x2_t v = {lo, hi}; bf16x2_t b = __builtin_convertvector(v, bf16x2_t); return __builtin_bit_cast(unsigned, b); }
typedef float f32x2 __attribute__((ext_vector_type(2)));
constexpr int MPR = 16384;
constexpr float EPS = 1e-6f, LOG2E = 1.4426950408889634f, QSCALE = 0.125f * 1.4426950408889634f;
__device__ __forceinline__ float sigm(float x) { return __builtin_amdgcn_rcpf(1.0f + __builtin_amdgcn_exp2f(-x * LOG2E)); }
__device__ __forceinline__ float dot4(f32x4 a) { return (a[0] * a[0] + a[1] * a[1]) + (a[2] * a[2] + a[3] * a[3]); }
typedef unsigned u32x2 __attribute__((ext_vector_type(2)));
__device__ __forceinline__ u32x4 pack8(f32x4 a, f32x4 b) { u32x4 w; w.x = cvt_pk_bf16(a[0], a[1]); w.y = cvt_pk_bf16(a[2], a[3]); w.z = cvt_pk_bf16(b[0], b[1]); w.w = cvt_pk_bf16(b[2], b[3]); return w; }

struct EpiIn {
    static constexpr bool PERM = true, AFTER_DRAIN = false;
    bf16_t* QB; float* HLF;
    static constexpr size_t BSTRIDE = (size_t)17 * 1024 * 1024 / 2; float *okp, *oks;   const float* rstd1; const float* gqk; const float* hlb;
    __device__ __forceinline__ void operator()(const f32x4 (&acc)[2][2][4][2], const Unit& u, int wr, int wc, int fr, int fq) const {
        const int type = u.pn >> 1;
        const int cl = (u.pn & 1) * 256 + wc * 64 + 8 * fq;
        const int row0 = u.pm * BM + wr * 64 + fr;
        float* const kvo = u.pm < 64 ? okp + (size_t)row0 * 512 : oks + (size_t)(row0 - MPR) * 512;
        const size_t vofs = u.pm < 64 ? (size_t)8388608 : (size_t)262144;
        float rs[2][4];
#pragma unroll
        for (int ai = 0; ai < 2; ++ai)
#pragma unroll
            for (int m = 0; m < 4; ++m) rs[ai][m] = rstd1[row0 + ai * HALF + m * 16];
        asm volatile("" : "+v"(rs[0][0]), "+v"(rs[0][1]), "+v"(rs[0][2]), "+v"(rs[0][3]), "+v"(rs[1][0]), "+v"(rs[1][1]), "+v"(rs[1][2]), "+v"(rs[1][3]));
        if (type <= 1) {
            const float* g = gqk + type * 128 + (wc & 1) * 64 + 8 * fq;
            f32x4 gv[2][2];
#pragma unroll
            for (int bj = 0; bj < 2; ++bj)
#pragma unroll
                for (int n = 0; n < 2; ++n) gv[bj][n] = *(const f32x4*)(g + 32 * bj + 4 * n);
            const float sc = type == 0 ? QSCALE : 1.0f;
#pragma unroll
            for (int ai = 0; ai < 2; ++ai)
#pragma unroll
                for (int m = 0; m < 4; ++m) {
                    const int row = row0 + ai * HALF + m * 16; f32x4 v[2][2]; float ss = 0.f;
#pragma unroll
                    for (int bj = 0; bj < 2; ++bj)
#pragma unroll
                        for (int n = 0; n < 2; ++n) { v[bj][n] = acc[ai][bj][m][n] * rs[ai][m]; ss += dot4(v[bj][n]); }
                    ss += __shfl_xor(ss, 16); ss += __shfl_xor(ss, 32);
                    const float rn = rsqrtf(ss * (1.0f / 64.0f) + EPS);
#pragma unroll
                    for (int bj = 0; bj < 2; ++bj) {
                        const f32x4 a = v[bj][0] * rn * gv[bj][0], b = v[bj][1] * rn * gv[bj][1];
                        if (type == 1) { float* ko = kvo + (size_t)(ai * HALF + m * 16) * 512 + cl + 32 * bj; *(f32x4*)ko = a; *(f32x4*)(ko + 4) = b; }
                        *(u32x4*)(QB + (size_t)type * BSTRIDE + (size_t)row * 512 + cl + 32 * bj) = pack8(a * sc, b * sc);
                    }
                }
        } else if (type == 4) {
            f32x4 lb[2][2];
#pragma unroll
            for (int bj = 0; bj < 2; ++bj)
#pragma unroll
                for (int n = 0; n < 2; ++n) { const f32x4 a = *(const f32x4*)(hlb + cl + 32 * bj + 4 * n), b = *(const f32x4*)(hlb + 512 + cl + 32 * bj + 4 * n);
#pragma unroll
                    for (int j = 0; j < 4; ++j) lb[bj][n][j] = sigm(a[j] - b[j]); }
#pragma unroll
            for (int ai = 0; ai < 2; ++ai)
#pragma unroll
                for (int m = 0; m < 4; ++m) {
                    const int row = row0 + ai * HALF + m * 16;
#pragma unroll
                    for (int bj = 0; bj < 2; ++bj)
#pragma unroll
                        for (int n = 0; n < 2; ++n) { f32x4 o;
#pragma unroll
                            for (int j = 0; j < 4; ++j) { const float z = acc[ai][bj][m][n][j] * rs[ai][m]; const float f = lb[bj][n][j] + (1.0f - lb[bj][n][j]) * sigm(z); o[j] = logf(f); }
                            *(f32x4*)(HLF + (size_t)row * 512 + cl + 32 * bj + 4 * n) = o; }
                }
        } else {
            bf16_t* dst = QB + (size_t)(type - (type > 4 ? 1 : 0)) * BSTRIDE;
#pragma unroll
            for (int ai = 0; ai < 2; ++ai)
#pragma unroll
                for (int m = 0; m < 4; ++m) {
                    const int row = row0 + ai * HALF + m * 16;
#pragma unroll
                    for (int bj = 0; bj < 2; ++bj) {
                        f32x4 a = acc[ai][bj][m][0] * rs[ai][m], b = acc[ai][bj][m][1] * rs[ai][m];
                        if (type == 2) { float* vo = kvo + vofs + (size_t)(ai * HALF + m * 16) * 512 + cl + 32 * bj; *(f32x4*)vo = a; *(f32x4*)(vo + 4) = b; }
                        if (type == 6) {
#pragma unroll
                            for (int j = 0; j < 4; ++j) { a[j] = a[j] * sigm(a[j]); b[j] = b[j] * sigm(b[j]); } }
                        *(u32x4*)(dst + (size_t)row * 512 + cl + 32 * bj) = pack8(a, b);
                    }
                }
        }
    }
};

struct EpiOut {
    static constexpr bool PERM = true, AFTER_DRAIN = false;
    const float *xp, *xs; float *yp, *ys; bf16_t* X1B; float* SSQP;
    __device__ __forceinline__ void operator()(const f32x4 (&acc)[2][2][4][2], const Unit& u, int wr, int wc, int fr, int fq) const {
        const int row0 = u.pm * BM + wr * 64 + fr, col0 = u.pn * BM + wc * 32 + 8 * fq;
        const float* const xb = u.pm < 64 ? xp + (size_t)row0 * 1024 : xs + (size_t)(row0 - MPR) * 1024; float* const yb = u.pm < 64 ? yp + (size_t)row0 * 1024 : ys + (size_t)(row0 - MPR) * 1024;
#pragma unroll
        for (int ai = 0; ai < 2; ++ai)
#pragma unroll
            for (int m = 0; m < 4; ++m) {
                const int row = row0 + ai * HALF + m * 16;
                const float* xin = xb + (size_t)(ai * HALF + m * 16) * 1024;
                float* yo = yb + (size_t)(ai * HALF + m * 16) * 1024;
                float ss = 0.f;
#pragma unroll
                for (int bj = 0; bj < 2; ++bj) { const int col = col0 + bj * HALF;
                    const f32x4 a = *(const f32x4*)(xin + col) + acc[ai][bj][m][0], b = *(const f32x4*)(xin + col + 4) + acc[ai][bj][m][1];
                    *(f32x4*)(yo + col) = a; *(f32x4*)(yo + col + 4) = b; ss += dot4(a) + dot4(b);
                    *(u32x4*)(X1B + (size_t)row * 1024 + col) = pack8(a, b); }
                ss += __shfl_xor(ss, 16); ss += __shfl_xor(ss, 32);
                if (fq == 0) SSQP[(size_t)row * 16 + u.pn * 4 + wc] = ss;
            }
    }
};

struct EpiDown {
    static constexpr bool PERM = true, AFTER_DRAIN = false;
    float *yp, *ys, *part;
    __device__ __forceinline__ void operator()(const f32x4 (&acc)[2][2][4][2], const Unit& u, int wr, int wc, int fr, int fq) const {
        const int row0 = u.pm * BM + wr * 64 + fr, col0 = u.pn * BM + wc * 32 + 8 * fq;
        float* const yb = u.pm < 64 ? yp + (size_t)row0 * 1024 : ys + (size_t)(row0 - MPR) * 1024;
#pragma unroll
        for (int ai = 0; ai < 2; ++ai)
#pragma unroll
            for (int m = 0; m < 4; ++m) {
                float* yo = yb + (size_t)(ai * HALF + m * 16) * 1024;
#pragma unroll
                for (int bj = 0; bj < 2; ++bj) { float* p = yo + col0 + bj * HALF;
                    if (u.pm >= 64) { float* pp = part + ((size_t)(u.kb >> 9) * 512 + (row0 - MPR + ai * HALF + m * 16)) * 1024 + col0 + bj * HALF;
                        *(f32x4*)pp = acc[ai][bj][m][0]; *(f32x4*)(pp + 4) = acc[ai][bj][m][1]; continue; }
                    f32x4 a = *(const f32x4*)p + acc[ai][bj][m][0], b = *(const f32x4*)(p + 4) + acc[ai][bj][m][1];
                    *(f32x4*)p = a; *(f32x4*)(p + 4) = b; }
            }
    }
};

struct EpiGU {
    static constexpr bool PERM = true, AFTER_DRAIN = false;
    bf16_t* G; const float* SSQP; const float *cw, *cb, *sconv; float *HALO_A, *HALO_U, *LASTA, *ocp, *ocs; PG8_LAS float* xch;
    __device__ __forceinline__ void operator()(const f32x4 (&acc)[2][2][4][2], const Unit& u, int wr, int wc, int fr, int fq) const {
        const int colt = u.pn * 128 + 32 * wc + 8 * fq;
        const int row0 = u.pm * BM + wr * 64 + fr;
        float rs[2][4];
#pragma unroll
        for (int ai = 0; ai < 2; ++ai)
#pragma unroll
            for (int m = 0; m < 4; ++m) { const f32x4* p = (const f32x4*)(SSQP + (size_t)(row0 + ai * HALF + m * 16) * 16); const f32x4 s = (p[0] + p[1]) + (p[2] + p[3]);
                rs[ai][m] = rsqrtf(((s[0] + s[1]) + (s[2] + s[3])) * (1.0f / 1024.0f) + EPS); }
        if (u.pm < 64) {
            if (fr >= 14) {
#pragma unroll
                for (int ai = 0; ai < 2; ++ai)
#pragma unroll
                    for (int n = 0; n < 2; ++n) *(PG8_LAS f32x4*)(xch + (((wr * 4 + wc) * 8 + (fr - 14) * 4 + fq) * 16 + ai * 8 + n * 4)) = acc[ai][0][3][n] * rs[ai][3];
            }
            asm volatile("s_waitcnt lgkmcnt(0)" ::: "memory"); __builtin_amdgcn_s_barrier(); asm volatile("" ::: "memory");
#pragma unroll
            for (int n = 0; n < 2; ++n) {
                const f32x4 w0 = *(const f32x4*)(cw + colt + 4 * n), w1 = *(const f32x4*)(cw + 2816 + colt + 4 * n), w2 = *(const f32x4*)(cw + 5632 + colt + 4 * n), bb = *(const f32x4*)(cb + colt + 4 * n);
#pragma unroll
                for (int ai = 0; ai < 2; ++ai) {
                    f32x4 prevA = {0.f, 0.f, 0.f, 0.f};
                    const bool has_prev = (wr == 1) || (ai == 1);
                    #ifndef DIAG_T3
                    if (has_prev && fr >= 14) { const int pw = (wr == 1 ? 0 : 4) + wc, pai = (wr == 1) ? ai : 0; prevA = *(const PG8_LAS f32x4*)(xch + ((pw * 8 + (fr - 14) * 4 + fq) * 16 + pai * 8 + n * 4)); }
#endif
#pragma unroll
                    for (int m = 0; m < 4; ++m) {
                        const int row = row0 + ai * HALF + m * 16;
                        const f32x4 a = acc[ai][0][m][n] * rs[ai][m], uu = acc[ai][1][m][n] * rs[ai][m]; f32x4 gg;
#pragma unroll
                        for (int j = 0; j < 4; ++j) {
                            const float up1 = __shfl_up(a[j], 1, 16), up2 = __shfl_up(a[j], 2, 16), t15 = __shfl(prevA[j], 15, 16), t14 = __shfl(prevA[j], 14, 16);
                            const float p1 = fr == 0 ? t15 : up1, p2 = fr == 0 ? t14 : (fr == 1 ? t15 : up2);
                            const float c = bb[j] + w0[j] * p2 + w1[j] * p1 + w2[j] * a[j];
                            gg[j] = c * sigm(c) * uu[j];
                        }
                        *(u32x2*)(G + (size_t)row * 2816 + colt + 4 * n) = (u32x2){cvt_pk_bf16(gg[0], gg[1]), cvt_pk_bf16(gg[2], gg[3])};
                        if (ai == 0 && m == 0 && wr == 0 && fr < 2) { *(f32x4*)(HALO_A + (size_t)(u.pm * 2 + fr) * 2816 + colt + 4 * n) = a; *(f32x4*)(HALO_U + (size_t)(u.pm * 2 + fr) * 2816 + colt + 4 * n) = uu; }
                        if (ai == 1 && m == 3 && wr == 1 && fr >= 14) { *(f32x4*)(LASTA + (size_t)(u.pm * 2 + fr - 14) * 2816 + colt + 4 * n) = a;
                            if ((u.pm & 31) == 31) *(f32x4*)(ocp + (size_t)((u.pm >> 5) * 2 + fr - 14) * 2816 + colt + 4 * n) = a; }
                        prevA = a;
                    }
                }
            }
        } else {
#pragma unroll
            for (int n = 0; n < 2; ++n) {
                const f32x4 w0 = *(const f32x4*)(cw + colt + 4 * n), w1 = *(const f32x4*)(cw + 2816 + colt + 4 * n), w2 = *(const f32x4*)(cw + 5632 + colt + 4 * n), bb = *(const f32x4*)(cb + colt + 4 * n);
#pragma unroll
                for (int ai = 0; ai < 2; ++ai)
#pragma unroll
                    for (int m = 0; m < 4; ++m) {
                        const int row = row0 + ai * HALF + m * 16, rl = row - MPR, bs = rl >> 2, t = rl & 3;
                        const f32x4 a = acc[ai][0][m][n] * rs[ai][m], uu = acc[ai][1][m][n] * rs[ai][m]; f32x4 gg, s0 = {0.f, 0.f, 0.f, 0.f}, s1 = {0.f, 0.f, 0.f, 0.f};
                        const float* sc = sconv + (size_t)bs * 2 * 2816 + colt + 4 * n;
                        if (t == 0) s0 = *(const f32x4*)sc;
                        if (t <= 1) s1 = *(const f32x4*)(sc + 2816);
#pragma unroll
                        for (int j = 0; j < 4; ++j) {
                            const float up1 = __shfl_up(a[j], 1, 16), up2 = __shfl_up(a[j], 2, 16);
                            const float p1 = t == 0 ? s1[j] : up1, p2 = t == 0 ? s0[j] : (t == 1 ? s1[j] : up2);
                            const float c = bb[j] + w0[j] * p2 + w1[j] * p1 + w2[j] * a[j];
                            gg[j] = c * sigm(c) * uu[j];
                        }
                        *(u32x2*)(G + (size_t)row * 2816 + colt + 4 * n) = (u32x2){cvt_pk_bf16(gg[0], gg[1]), cvt_pk_bf16(gg[2], gg[3])};
                        if (t >= 2) *(f32x4*)(ocs + (size_t)(bs * 2 + t - 2) * 2816 + colt + 4 * n) = a;
                    }
            }
        }
    }
};
template <class Epi, class Sched, bool ALIGN_EPI = false, bool SP2 = false>
__device__ __forceinline__ void gemm_phase(PG8_LAS unsigned char* lds, const Gemm g, const Sched& S, const Epi& E) {
    int tid_ = threadIdx.x; asm volatile("" : "+v"(tid_));
    const int tid = tid_, wid = __builtin_amdgcn_readfirstlane(tid >> 6), lane = tid & 63, wr = wid >> 2, wc = wid & 3, fr = lane & 15, fq = lane >> 4;
    const int K = g.ldk, nt_def = g.K / BK;
    unsigned voffA[2], voffB[2];
#pragma unroll
    for (int i = 0; i < 2; ++i) { int R, C; stage_rc(tid * 16 + i * 8192, R, C); const int Rb = Epi::PERM ? ((R & ~31) + perm32(R & 31)) : R;
        voffA[i] = (unsigned)(R * K + C) * 2u; voffB[i] = (unsigned)(Rb * K + C) * 2u; }
    const size_t kstep = (size_t)(BK * 2);
    const size_t hstep = (size_t)HALF * K * 2;
    const size_t tstep = 2 * hstep;
    const unsigned ldsw = (unsigned)wid * 1024u;
    const int aoff = lds_byte(wr * 64 + fr, fq * 8), boff = lds_byte(wc * 32 + fr, fq * 8);
#define PG8_SA(b, h) (((b) * 2 + (h)) * HTB)
#define PG8_SB(b, h) ((4 + (b) * 2 + (h)) * HTB)
#define PG8_STAGE(bufoff, gbase, voff) do { _Pragma("unroll") for (int _i = 0; _i < 2; ++_i) \
        __builtin_amdgcn_global_load_lds((const unsigned*)((const char*)(gbase) + (voff)[_i]), (PG8_LAS unsigned*)(lds + (bufoff) + ldsw + _i * 8192), 16, 0, 0); } while (0)
#define PG8_LDA(dst, b, h) do { _Pragma("unroll") for (int m = 0; m < 4; ++m) _Pragma("unroll") for (int k = 0; k < 2; ++k) dst[m][k] = *(const PG8_LAS bf16x8*)(lds + PG8_SA(b, h) + aoff + m * 2048 + k * 1024); } while (0)
#define PG8_LDB(dst, b, h) do { _Pragma("unroll") for (int n = 0; n < 2; ++n) _Pragma("unroll") for (int k = 0; k < 2; ++k) dst[n][k] = *(const PG8_LAS bf16x8*)(lds + PG8_SB(b, h) + boff + n * 2048 + k * 1024); } while (0)
#define PG8_MMA(ai, bj, At, Bt) do { __builtin_amdgcn_s_setprio(1); _Pragma("unroll") for (int m = 0; m < 4; ++m) _Pragma("unroll") for (int n = 0; n < 2; ++n) _Pragma("unroll") for (int k = 0; k < 2; ++k) \
        acc[ai][bj][m][n] = __builtin_amdgcn_mfma_f32_16x16x32_bf16(Bt[n][k], At[m][k], acc[ai][bj][m][n], 0, 0, 0); __builtin_amdgcn_s_setprio(0); } while (0)
#define PG8_WAIT_V(n) asm volatile("s_waitcnt vmcnt(" #n ")" ::: "memory")
#define PG8_WAIT_L(n) asm volatile("s_waitcnt lgkmcnt(" #n ")" ::: "memory")
#define PG8_BAR __builtin_amdgcn_s_barrier()
#define PG8_SCHED __builtin_amdgcn_sched_barrier(0)
    Unit cur, nxt; int ui = 0;
    if (!S.next(0, cur)) return;
    f32x4 acc[2][2][4][2];
#pragma unroll
    for (int a = 0; a < 2; ++a)
#pragma unroll
        for (int b = 0; b < 2; ++b)
#pragma unroll
            for (int m = 0; m < 4; ++m)
#pragma unroll
                for (int n = 0; n < 2; ++n) acc[a][b][m][n] = (f32x4){0.f, 0.f, 0.f, 0.f};
    bf16x8 At[4][2], B0[2][2], B1[2][2];
    const char* cA = (const char*)g.A + (size_t)cur.pm * tstep + cur.kb; const char* cB = (const char*)g.Bt + (size_t)cur.pn * tstep + cur.kb;
    S.a_ready(cur);
    if constexpr (SP2) {
        PG8_STAGE(PG8_SB(0, 0), cB, voffB); PG8_STAGE(PG8_SB(0, 1), cB + hstep, voffB); PG8_STAGE(PG8_SA(0, 0), cA, voffA); PG8_STAGE(PG8_SA(0, 1), cA + hstep, voffA);
        if (wr == 1) PG8_BAR;
        PG8_WAIT_V(2); PG8_BAR;
        PG8_STAGE(PG8_SB(1, 0), cB + kstep, voffB); PG8_STAGE(PG8_SA(1, 0), cA + kstep, voffA); PG8_STAGE(PG8_SB(1, 1), cB + hstep + kstep, voffB);
        PG8_WAIT_V(6); PG8_BAR;
    } else {
        PG8_STAGE(PG8_SB(0, 0), cB, voffB); PG8_STAGE(PG8_SA(0, 0), cA, voffA); PG8_STAGE(PG8_SB(0, 1), cB + hstep, voffB); PG8_STAGE(PG8_SA(0, 1), cA + hstep, voffA);
        if (wr == 1) PG8_BAR;
        PG8_WAIT_V(4); PG8_BAR;
        PG8_STAGE(PG8_SB(1, 0), cB + kstep, voffB); PG8_STAGE(PG8_SA(1, 0), cA + kstep, voffA); PG8_STAGE(PG8_SB(1, 1), cB + hstep + kstep, voffB);
        PG8_WAIT_V(6); PG8_BAR;
    }
    for (;;) {
        const bool has_next = S.next(ui + 1, nxt);
        const char* nA = has_next ? (const char*)g.A + (size_t)nxt.pm * tstep + nxt.kb : cA; const char* nB = has_next ? (const char*)g.Bt + (size_t)nxt.pn * tstep + nxt.kb : cB;
        const int nt = cur.nt ? cur.nt : nt_def;
        for (int t = 0; t < nt; t += 2) {
            const bool last = (t == nt - 2);
            const char* a1 = cA + (size_t)(t + 1) * kstep;
            const char* a2 = last ? nA : cA + (size_t)(t + 2) * kstep; const char* b2 = last ? nB : cB + (size_t)(t + 2) * kstep;
            const char* a3 = a2 + kstep; const char* b3 = b2 + kstep;
            if (last && has_next) S.a_ready(nxt);
            if constexpr (SP2) {
            PG8_LDB(B0, 0, 0); PG8_LDB(B1, 0, 1); PG8_SCHED; PG8_LDA(At, 0, 0); PG8_STAGE(PG8_SA(1, 1), a1 + hstep, voffA);
            PG8_WAIT_V(8); PG8_WAIT_L(0); PG8_BAR; PG8_MMA(0, 0, At, B0); PG8_MMA(0, 1, At, B1); PG8_BAR; PG8_SCHED;
            PG8_LDA(At, 0, 1); PG8_STAGE(PG8_SB(0, 0), b2, voffB); PG8_STAGE(PG8_SB(0, 1), b2 + hstep, voffB); PG8_STAGE(PG8_SA(0, 0), a2, voffA);
            PG8_WAIT_V(8); PG8_WAIT_L(0); PG8_BAR; PG8_MMA(1, 0, At, B0); PG8_MMA(1, 1, At, B1); PG8_BAR; PG8_SCHED;
            PG8_LDB(B0, 1, 0); PG8_LDB(B1, 1, 1); PG8_SCHED; PG8_LDA(At, 1, 0); PG8_STAGE(PG8_SA(0, 1), a2 + hstep, voffA);
            PG8_WAIT_V(8); PG8_WAIT_L(0); PG8_BAR; PG8_MMA(0, 0, At, B0); PG8_MMA(0, 1, At, B1); PG8_BAR; PG8_SCHED;
            PG8_LDA(At, 1, 1); PG8_STAGE(PG8_SB(1, 0), b3, voffB); PG8_STAGE(PG8_SB(1, 1), b3 + hstep, voffB); PG8_STAGE(PG8_SA(1, 0), a3, voffA);
            PG8_WAIT_V(8); PG8_WAIT_L(0); PG8_BAR; PG8_MMA(1, 0, At, B0); PG8_MMA(1, 1, At, B1); PG8_BAR; PG8_SCHED;
            } else {
            PG8_LDB(B0, 0, 0); PG8_SCHED; PG8_LDA(At, 0, 0); PG8_STAGE(PG8_SA(1, 1), a1 + hstep, voffA);
            PG8_WAIT_L(8); PG8_BAR; PG8_WAIT_L(0); PG8_MMA(0, 0, At, B0); PG8_BAR; PG8_SCHED;
            PG8_LDB(B1, 0, 1); PG8_STAGE(PG8_SB(0, 0), b2, voffB);
            PG8_BAR; PG8_WAIT_L(0); PG8_MMA(0, 1, At, B1); PG8_BAR;
            PG8_LDA(At, 0, 1); PG8_STAGE(PG8_SA(0, 0), a2, voffA);
            PG8_BAR; PG8_WAIT_L(0); PG8_MMA(1, 0, At, B0); PG8_BAR; PG8_SCHED;
            PG8_STAGE(PG8_SB(0, 1), b2 + hstep, voffB);
            PG8_WAIT_V(6); PG8_BAR; PG8_MMA(1, 1, At, B1); PG8_BAR;
            PG8_LDB(B0, 1, 0); PG8_SCHED; PG8_LDA(At, 1, 0); PG8_STAGE(PG8_SA(0, 1), a2 + hstep, voffA);
            PG8_WAIT_L(8); PG8_BAR; PG8_WAIT_L(0); PG8_MMA(0, 0, At, B0); PG8_BAR; PG8_SCHED;
            PG8_LDB(B1, 1, 1); PG8_STAGE(PG8_SB(1, 0), b3, voffB);
            PG8_BAR; PG8_WAIT_L(0); PG8_MMA(0, 1, At, B1); PG8_BAR;
            PG8_LDA(At, 1, 1); PG8_STAGE(PG8_SA(1, 0), a3, voffA);
            PG8_BAR; PG8_WAIT_L(0); PG8_MMA(1, 0, At, B0); PG8_BAR; PG8_SCHED;
            PG8_STAGE(PG8_SB(1, 1), b3 + hstep, voffB);
            PG8_WAIT_V(6); PG8_BAR; PG8_MMA(1, 1, At, B1); PG8_BAR;
            }
        }
        if constexpr (ALIGN_EPI) { if (wr == 0) PG8_BAR; }
        if constexpr (!Epi::AFTER_DRAIN) { int l_; asm volatile("v_mbcnt_lo_u32_b32 %0, -1, 0\n\tv_mbcnt_hi_u32_b32 %0, -1, %0" : "=v"(l_)); E(acc, cur, wr, wc, l_ & 15, l_ >> 4); S.done(cur); }
        if (!has_next) break;
#pragma unroll
        for (int a = 0; a < 2; ++a)
#pragma unroll
            for (int b = 0; b < 2; ++b)
#pragma unroll
                for (int m = 0; m < 4; ++m)
#pragma unroll
                    for (int n = 0; n < 2; ++n) acc[a][b][m][n] = (f32x4){0.f, 0.f, 0.f, 0.f};
        cur = nxt; cA = nA; cB = nB; ++ui;
        if constexpr (ALIGN_EPI) { if (wr == 1) PG8_BAR; }
    }
    PG8_WAIT_V(0);
    if constexpr (!ALIGN_EPI) { if (wr == 0) PG8_BAR; }
    PG8_BAR;
    if constexpr (Epi::AFTER_DRAIN) { E.fused(acc, cur, wr, wc, fr, fq, lds, wid, lane); S.done(cur); }
#undef PG8_SA
#undef PG8_SB
#undef PG8_STAGE
#undef PG8_LDA
#undef PG8_LDB
#undef PG8_MMA
#undef PG8_WAIT_V
#undef PG8_WAIT_L
#undef PG8_BAR
#undef PG8_SCHED
}
}

#ifndef PG8_SP2
#define PG8_SP2 true
#endif
#ifndef PG8_ALIGN
#define PG8_ALIGN true
#endif
constexpr int NWAVES = 8;
constexpr int DM = 1024, TP = 8192, NBP = 2, MP = NBP * TP, NBS = 128, TS = 4, MS = NBS * TS, MALL = MP + MS;
constexpr int NIN = 3584, DFF = 2816, NPAGES = 16, PAGE = 128, PAST = 2048;
constexpr float EPSF = 1e-6f, LOG2E_F = 1.4426950408889634f;
constexpr size_t O_YP = 0, O_YS = 16777216, O_KP = 17301504, O_VP = 25690112, O_HP = 34078720, O_CP = 34209792, O_KS = 34221056, O_VS = 34483200, O_HS = 34745344, O_CS = 43133952, O_END = 43854848;
constexpr size_t MiB = 1u << 20;
constexpr size_t WS_CTL = 0, CTL_ZERO_BYTES = 1 * MiB;
constexpr size_t WS_WIN = 2 * MiB;
constexpr size_t WS_WOUT = 10 * MiB;
constexpr size_t WS_WGU = 12 * MiB;
constexpr size_t WS_WDN = 24 * MiB;
constexpr size_t WS_RSTD1 = 30 * MiB;
constexpr size_t WS_SSQP = 31 * MiB;
constexpr size_t WS_HALOA = 33 * MiB, WS_HALOU = 35 * MiB, WS_LASTA = 37 * MiB;
constexpr size_t WS_DTOT = 39 * MiB;
constexpr size_t WS_XB = 40 * MiB;
constexpr size_t WS_QB = 74 * MiB, WS_KB = 91 * MiB, WS_VB = 108 * MiB, WS_HQ = 125 * MiB, WS_HV = 142 * MiB, WS_HG = 159 * MiB;
constexpr size_t WS_HLF = 176 * MiB;
constexpr size_t WS_MIX = 210 * MiB;
constexpr size_t WS_X1B = 244 * MiB;
constexpr size_t WS_UBUF = 278 * MiB;
constexpr size_t WS_SST = 295 * MiB;
constexpr size_t WS_G = 312 * MiB;
constexpr size_t WS_PART = 404 * MiB;
constexpr size_t WS_END = 428 * MiB;
constexpr int CW_TMO = 0, CW_BAR = 4096, CW_QDEC = 8192, CW_QATT = 8256;
constexpr int RING_OFF = 0, RING_BYTES = 131072;
constexpr int LDSCTL_OFF = RING_BYTES, MISC_OFF = LDSCTL_OFF + 320;
constexpr int BL_OFF = RING_BYTES + 512;
constexpr int SCAL_OFF = BL_OFF + 2048;
constexpr int XCH_OFF = SCAL_OFF + 128;
constexpr int ALS_OFF = XCH_OFF + 4096;
constexpr int LDS_BYTES = 147456;
static_assert(ALS_OFF + 1024 <= LDS_BYTES, "LDS map");

#define GAS __attribute__((address_space(1)))
#define LAS __attribute__((address_space(3)))
typedef unsigned short bf16;
typedef unsigned v4u __attribute__((ext_vector_type(4)));
typedef unsigned v2u __attribute__((ext_vector_type(2)));
typedef float f32x4 __attribute__((ext_vector_type(4)));
typedef float f32x16 __attribute__((ext_vector_type(16)));
typedef short bf16x8 __attribute__((ext_vector_type(8)));
typedef short s16x4 __attribute__((ext_vector_type(4)));
typedef GAS unsigned gu32;
#define RLX_AGENT __ATOMIC_RELAXED, __HIP_MEMORY_SCOPE_AGENT
#define LDS_WAIT() asm volatile("s_waitcnt lgkmcnt(0)" ::: "memory")
#define VM_WAIT() asm volatile("s_waitcnt vmcnt(0)" ::: "memory")
#define WG_SYNC() do { asm volatile("s_waitcnt vmcnt(0) lgkmcnt(0)" ::: "memory"); __builtin_amdgcn_s_barrier(); asm volatile("" ::: "memory"); } while (0)
#define LDS_SYNC() do { asm volatile("s_waitcnt lgkmcnt(0)" ::: "memory"); __builtin_amdgcn_s_barrier(); asm volatile("" ::: "memory"); } while (0)
__device__ __forceinline__ unsigned f2bf(float f) { unsigned u = __builtin_bit_cast(unsigned, f); return (u + 0x7fffu + ((u >> 16) & 1u)) >> 16; }
__device__ __forceinline__ unsigned pk2(float lo, float hi) { return pg8::cvt_pk_bf16(lo, hi); }
__device__ __forceinline__ float bf2f(unsigned short h) { return __builtin_bit_cast(float, (unsigned)h << 16); }
__device__ __forceinline__ float sigm_f(float x) { return __builtin_amdgcn_rcpf(1.0f + __builtin_amdgcn_exp2f(-x * LOG2E_F)); }
__device__ __forceinline__ float ex2(float x) { return __builtin_amdgcn_exp2f(x); }
__device__ __forceinline__ int crow(int r, int hi) { return (r & 3) + 8 * (r >> 2) + 4 * hi; }
#define XB_TMO      128
#define XB_XCNT(j)  (256  + 64 * (j))
#define XB_XSUB(j)  (1280 + 64 * (j))
#define XB_XGEN(j)  (2304 + 64 * (j))
#define XB_TOP      3328
#define XB_TOPGEN   3392
#define XCD_BAR_WORDS 3456
#define XB_SPIN_CAP (1u << 18)

__device__ __forceinline__ unsigned xb_ld(unsigned* p)              { return __hip_atomic_load(p, __ATOMIC_RELAXED, __HIP_MEMORY_SCOPE_AGENT); }
__device__ __forceinline__ unsigned xb_add(unsigned* p, unsigned v) { return __hip_atomic_fetch_add(p, v, __ATOMIC_RELAXED, __HIP_MEMORY_SCOPE_AGENT); }
__device__ __forceinline__ unsigned xb_xcc_id() { return (unsigned)__builtin_amdgcn_s_getreg((3 << 11) | 20) & 0xFu; }
#define XB_SPIN(cond, bar) do { unsigned _sp = 0; while (cond) { __builtin_amdgcn_s_sleep(1); \
    if ((++_sp & 255u) == 0u) { if (xb_ld(&(bar)[XB_TMO])) break; if (_sp > XB_SPIN_CAP) { atomicAdd(&(bar)[XB_TMO], 1u); break; } } } } while (0)

struct XcdBarrier {
    unsigned* bar; unsigned x;
    volatile LAS unsigned* st;
};

__device__ __forceinline__ XcdBarrier xcd_barrier_post(unsigned* bar, volatile LAS unsigned* st) {
    XcdBarrier b; b.bar = bar; b.x = xb_xcc_id(); b.st = st;
    if (threadIdx.x == 0) (void)xb_add(&bar[XB_XCNT(b.x)], 1u);
    return b;
}
__device__ __forceinline__ void xcd_barrier_complete(unsigned* bar, unsigned x, unsigned& nloc, unsigned& nx) {
    const unsigned G = gridDim.x * gridDim.y * gridDim.z;
    unsigned sum, cnt, mine, sp = 0u;
    for (;;) {
        sum = 0u; cnt = 0u; mine = 0u;
#pragma unroll
        for (unsigned j = 0; j < 16; ++j) { const unsigned c = xb_ld(&bar[XB_XCNT(j)]); sum += c; cnt += (c > 0u) ? 1u : 0u; mine = (j == x) ? c : mine; }
        if (sum == G) break;
        __builtin_amdgcn_s_sleep(1);
        if ((++sp & 255u) == 0u) { if (xb_ld(&bar[XB_TMO])) break; if (sp > XB_SPIN_CAP) { atomicAdd(&bar[XB_TMO], 1u); break; } }
    }
    nloc = mine > 0u ? mine : 1u; nx = cnt > 0u ? cnt : 1u;
}

__device__ __forceinline__ void xcd_barrier(const XcdBarrier& b) {
    asm volatile("s_waitcnt vmcnt(0)" ::: "memory");
    __syncthreads();
    if (threadIdx.x == 0) {
        unsigned* bar = b.bar;
        __builtin_amdgcn_s_waitcnt(0);
        unsigned nloc = b.st[0], nx = b.st[1];
        if (nloc == 0u) { xcd_barrier_complete(bar, b.x, nloc, nx); b.st[0] = nloc; b.st[1] = nx; }
        const unsigned old = xb_add(&bar[XB_XSUB(b.x)], 1u);
        const unsigned gen = old / nloc;
        if (old + 1u == (gen + 1u) * nloc) {
            __builtin_amdgcn_fence(__ATOMIC_RELEASE, "agent");
            asm volatile("s_waitcnt vmcnt(0)" ::: "memory");
            const unsigned og = xb_add(&bar[XB_TOP], 1u);
            const unsigned tg = og / nx;
            if (og + 1u == (tg + 1u) * nx) xb_add(&bar[XB_TOPGEN], 1u);
            else XB_SPIN(xb_ld(&bar[XB_TOPGEN]) == tg, bar);
            __builtin_amdgcn_fence(__ATOMIC_ACQUIRE, "agent");
            xb_add(&bar[XB_XGEN(b.x)], 1u);
            asm volatile("s_waitcnt vmcnt(0)" ::: "memory");
        } else {
            XB_SPIN(xb_ld(&bar[XB_XGEN(b.x)]) == gen, bar);
            __builtin_amdgcn_fence(__ATOMIC_ACQUIRE, "agent");
            asm volatile("s_waitcnt vmcnt(0)" ::: "memory");
        }
    }
    __syncthreads();
}

__device__ __forceinline__ float wave_sum(float v) {
#pragma unroll
    for (int o = 1; o < 64; o <<= 1) v += __shfl_xor(v, o);
    return v;
}
template <class KS>
__device__ __forceinline__ void p0_transpose_item(const float* W, int K, int N, bf16* WT, int kb, int nb, int prow, LAS float* scr, int lane, const KS& ks) {
    const int k0 = 64 * kb, n0 = 32 * nb;
#pragma unroll 8
    for (int i = 0; i < 32; ++i) { const int kk = 2 * i + (lane >> 5); scr[kk * 33 + (lane & 31)] = W[(size_t)(k0 + kk) * N + n0 + (lane & 31)] * ks(k0 + kk); }
    LDS_WAIT(); asm volatile("" ::: "memory");
    const int c = lane & 7;
#pragma unroll
    for (int j = 0; j < 4; ++j) { const int n = (lane >> 3) + 8 * j; const LAS float* s = scr + (8 * c) * 33 + n;
        v4u o; o.x = pk2(s[0 * 33], s[1 * 33]); o.y = pk2(s[2 * 33], s[3 * 33]); o.z = pk2(s[4 * 33], s[5 * 33]); o.w = pk2(s[6 * 33], s[7 * 33]);
        *(GAS v4u*)(WT + (size_t)(prow + n) * K + k0 + 8 * c) = o; }
    LDS_WAIT(); asm volatile("" ::: "memory");
}
struct PIn {
    const float *xp, *xs, *ck, *cv; const int* pt; const float *sh, *sconv, *relb, *g1, *win, *gqk, *lqk, *subg, *hlb, *ong, *wout, *g2, *wg, *wu, *cw, *cb, *wd;
};
constexpr int H_QT = 0, H_KI = 17408, H_KET = 34816, H_VT = 53248, H_ST = 71680, H_P = 106496, H_DEC = 115712, H_TOT = 116224, H_END = 118272;
static_assert(H_END <= RING_BYTES, "hgrn LDS");
#define MFMA32(a, b, c) __builtin_amdgcn_mfma_f32_32x32x16_bf16((a), (b), (c), 0, 0, 0)
template <bool OUT>
__device__ __forceinline__ void hgrn_unit(int unit, LAS unsigned char* lds, const float* HLF, const bf16* HQ, const bf16* HV, const bf16* HG, bf16* MIX, float* UBUF, float* DTOT, const float* SST) {
    const int tid = threadIdx.x, lane = tid & 63, wid = __builtin_amdgcn_readfirstlane(tid >> 6), r32 = lane & 31, hi = lane >> 5;
    const int bh = unit >> 5, sc = unit & 31, b = bh >> 2, h = bh & 3, col0 = h * 128;
    const int row_base = b * TP + sc * 256, kx = tid & 127, tq = tid >> 7;
    const int ki = wid & 3, vi0 = 2 * (wid >> 2);
    LAS bf16* QT = (LAS bf16*)(lds + H_QT); LAS bf16* KI = (LAS bf16*)(lds + H_KI); LAS bf16* KET = (LAS bf16*)(lds + H_KET); LAS bf16* VT = (LAS bf16*)(lds + H_VT);
    LAS bf16* ST = (LAS bf16*)(lds + H_ST); LAS bf16* PP = (LAS bf16*)(lds + H_P); LAS float* DEC = (LAS float*)(lds + H_DEC); LAS float* TOT = (LAS float*)(lds + H_TOT);
    LAS float* OS = (LAS float*)(lds + H_QT);
    f32x16 S[2];
#pragma unroll
    for (int j = 0; j < 2; ++j)
#pragma unroll
        for (int r = 0; r < 16; ++r) S[j][r] = OUT ? SST[(size_t)unit * 16384 + (32 * ki + crow(r, hi)) * 128 + 32 * (vi0 + j) + r32] : 0.f;
    float dacc = 0.f;
    for (int c = 0; c < 4; ++c) {
        const int rows = row_base + 64 * c + 16 * tq;
        float cs[16]; unsigned short vv[16], qq[16];
#pragma unroll
        for (int i = 0; i < 16; ++i) { cs[i] = HLF[(size_t)(rows + i) * 512 + col0 + kx]; vv[i] = HV[(size_t)(rows + i) * 512 + col0 + kx]; if (OUT) qq[i] = HQ[(size_t)(rows + i) * 512 + col0 + kx]; }
        float lf[16];
#pragma unroll
        for (int i = 0; i < 16; ++i) { lf[i] = cs[i]; if (i) cs[i] += cs[i - 1]; }
        TOT[tq * 128 + kx] = cs[15];
        LDS_SYNC();
        float off = 0.f, blast = 0.f;
#pragma unroll
        for (int q = 0; q < 4; ++q) { const float t = TOT[q * 128 + kx]; if (q < tq) off += t; blast += t; }
        unsigned kew[8], vtw[8];
#pragma unroll
        for (int i = 0; i < 16; i += 2) {
            float ke[2];
#pragma unroll
            for (int e = 0; e < 2; ++e) { const float bi = off + cs[i + e], kk = 1.0f - ex2(lf[i + e] * LOG2E_F); ke[e] = kk * ex2((blast - bi) * LOG2E_F);
                if (OUT) { QT[(16 * tq + i + e) * 136 + kx] = (bf16)f2bf(bf2f(qq[i + e]) * ex2(bi * LOG2E_F)); KI[(16 * tq + i + e) * 136 + kx] = (bf16)f2bf(kk * ex2(-bi * LOG2E_F)); } }
            kew[i >> 1] = pk2(ke[0], ke[1]); vtw[i >> 1] = (unsigned)vv[i] | ((unsigned)vv[i + 1] << 16);
        }
        *(LAS v4u*)(KET + kx * 72 + 16 * tq) = (v4u){kew[0], kew[1], kew[2], kew[3]}; *(LAS v4u*)(KET + kx * 72 + 16 * tq + 8) = (v4u){kew[4], kew[5], kew[6], kew[7]};
        *(LAS v4u*)(VT + kx * 72 + 16 * tq) = (v4u){vtw[0], vtw[1], vtw[2], vtw[3]}; *(LAS v4u*)(VT + kx * 72 + 16 * tq + 8) = (v4u){vtw[4], vtw[5], vtw[6], vtw[7]};
        if (tq == 0) { DEC[kx] = ex2(blast * LOG2E_F); dacc += blast; }
        if (OUT && c == 0) {
#pragma unroll
            for (int j = 0; j < 2; ++j)
#pragma unroll
                for (int g = 0; g < 4; ++g) *(LAS v2u*)(ST + (32 * (vi0 + j) + r32) * 136 + 32 * ki + 8 * g + 4 * hi) = (v2u){pk2(S[j][4 * g], S[j][4 * g + 1]), pk2(S[j][4 * g + 2], S[j][4 * g + 3])};
        }
        LDS_SYNC();
        f32x16 oacc;
        if (OUT) {
            if (wid < 3) {
                const int ti = wid > 0, si = wid == 2; f32x16 am;
#pragma unroll
                for (int r = 0; r < 16; ++r) am[r] = 0.f;
#pragma unroll
                for (int ks = 0; ks < 8; ++ks) { const bf16x8 a = *(const LAS bf16x8*)(QT + (32 * ti + r32) * 136 + 16 * ks + 8 * hi), bb = *(const LAS bf16x8*)(KI + (32 * si + r32) * 136 + 16 * ks + 8 * hi); am = MFMA32(a, bb, am); }
#pragma unroll
                for (int r = 0; r < 16; ++r) { const int t = 32 * ti + crow(r, hi), s = 32 * si + r32; PP[t * 72 + s] = (bf16)f2bf(s <= t ? am[r] : 0.f); }
            } else if (wid == 3) {
#pragma unroll
                for (int r = 0; r < 16; ++r) PP[crow(r, hi) * 72 + 32 + r32] = 0;
            }
            LDS_SYNC();
            const int ti = wid & 1, vi = wid >> 1;
#pragma unroll
            for (int r = 0; r < 16; ++r) oacc[r] = 0.f;
#pragma unroll
            for (int ks = 0; ks < 4; ++ks) { const bf16x8 a = *(const LAS bf16x8*)(PP + (32 * ti + r32) * 72 + 16 * ks + 8 * hi), bb = *(const LAS bf16x8*)(VT + (32 * vi + r32) * 72 + 16 * ks + 8 * hi); oacc = MFMA32(a, bb, oacc); }
#pragma unroll
            for (int ks = 0; ks < 8; ++ks) { const bf16x8 a = *(const LAS bf16x8*)(QT + (32 * ti + r32) * 136 + 16 * ks + 8 * hi), bb = *(const LAS bf16x8*)(ST + (32 * vi + r32) * 136 + 16 * ks + 8 * hi); oacc = MFMA32(a, bb, oacc); }
        }
        {
            float dk[16];
#pragma unroll
            for (int r = 0; r < 16; ++r) dk[r] = DEC[32 * ki + crow(r, hi)];
#pragma unroll
            for (int j = 0; j < 2; ++j)
#pragma unroll
                for (int r = 0; r < 16; ++r) S[j][r] *= dk[r];
#pragma unroll
            for (int ks = 0; ks < 4; ++ks) { const bf16x8 a = *(const LAS bf16x8*)(KET + (32 * ki + r32) * 72 + 16 * ks + 8 * hi);
#pragma unroll
                for (int j = 0; j < 2; ++j) { const bf16x8 bb = *(const LAS bf16x8*)(VT + (32 * (vi0 + j) + r32) * 72 + 16 * ks + 8 * hi); S[j] = MFMA32(a, bb, S[j]); } }
        }
        if (OUT) {
            LDS_SYNC();
            const int ti = wid & 1, vi = wid >> 1;
#pragma unroll
            for (int r = 0; r < 16; ++r) OS[(32 * ti + crow(r, hi)) * 132 + 32 * vi + r32] = oacc[r];
#pragma unroll
            for (int j = 0; j < 2; ++j)
#pragma unroll
                for (int g = 0; g < 4; ++g) *(LAS v2u*)(ST + (32 * (vi0 + j) + r32) * 136 + 32 * ki + 8 * g + 4 * hi) = (v2u){pk2(S[j][4 * g], S[j][4 * g + 1]), pk2(S[j][4 * g + 2], S[j][4 * g + 3])};
            LDS_SYNC();
            const int t = tid >> 3, seg = tid & 7; const int row = row_base + 64 * c + t;
            f32x4 o4[4]; float ss = 0.f;
#pragma unroll
            for (int i = 0; i < 4; ++i) { o4[i] = *(const LAS f32x4*)(OS + t * 132 + 16 * seg + 4 * i); ss += (o4[i][0] * o4[i][0] + o4[i][1] * o4[i][1]) + (o4[i][2] * o4[i][2] + o4[i][3] * o4[i][3]); }
            ss += __shfl_xor(ss, 1); ss += __shfl_xor(ss, 2); ss += __shfl_xor(ss, 4);
            const float rstd = rsqrtf(ss * (1.0f / 128.0f) + EPSF);
            const v4u g0 = *(const v4u*)(HG + (size_t)row * 512 + col0 + 16 * seg), g1 = *(const v4u*)(HG + (size_t)row * 512 + col0 + 16 * seg + 8);
            const unsigned gw[8] = {g0.x, g0.y, g0.z, g0.w, g1.x, g1.y, g1.z, g1.w}; unsigned ow[8];
#pragma unroll
            for (int i = 0; i < 8; ++i) { const float a = o4[i >> 1][2 * (i & 1)] * rstd * __builtin_bit_cast(float, gw[i] << 16), bq = o4[i >> 1][2 * (i & 1) + 1] * rstd * __builtin_bit_cast(float, gw[i] & 0xffff0000u); ow[i] = pk2(a, bq); }
            *(v4u*)(MIX + (size_t)row * 1024 + 512 + col0 + 16 * seg) = (v4u){ow[0], ow[1], ow[2], ow[3]}; *(v4u*)(MIX + (size_t)row * 1024 + 512 + col0 + 16 * seg + 8) = (v4u){ow[4], ow[5], ow[6], ow[7]};
        }
        LDS_SYNC();
    }
    if (!OUT) {
#pragma unroll
        for (int j = 0; j < 2; ++j)
#pragma unroll
            for (int r = 0; r < 16; ++r) UBUF[(size_t)unit * 16384 + (32 * ki + crow(r, hi)) * 128 + 32 * (vi0 + j) + r32] = S[j][r];
        if (tq == 0) DTOT[unit * 128 + kx] = ex2(dacc * LOG2E_F);
    }
}
__device__ __forceinline__ void hgrn_scan(int gtid, int gsize, const float* UBUF, const float* DTOT, float* SST, float* ohp) {
    for (int e = gtid; e < 8 * 16384; e += gsize) {
        const int bh = e >> 14, idx = e & 16383, k = idx >> 7; float s = 0.f;
#pragma unroll 8
        for (int sc = 0; sc < 32; ++sc) { const int unit = bh * 32 + sc; SST[(size_t)unit * 16384 + idx] = s; s = DTOT[unit * 128 + k] * s + UBUF[(size_t)unit * 16384 + idx]; }
        ohp[(size_t)bh * 16384 + idx] = s;
    }
}
__device__ __forceinline__ void hgrn_sample_unit(int unit, LAS unsigned char* lds, const float* sh, const float* HLF, const bf16* HQ, const bf16* HV, const bf16* HG, bf16* MIX, float* ohs) {
    const int tid = threadIdx.x, wid = tid >> 6, b = unit >> 2, h = unit & 3, v4 = tid & 31, kq = tid >> 5;
    LAS float* OP = (LAS float*)lds;
    LAS float* PS = (LAS float*)(lds + 32768);
    const float* s0 = sh + ((size_t)unit * 128 + 8 * kq) * 128 + 4 * v4;
    f32x4 S[8];
#pragma unroll
    for (int i = 0; i < 8; ++i) S[i] = *(const f32x4*)(s0 + i * 128);
#pragma unroll
    for (int t = 0; t < 4; ++t) {
        const size_t rb = (size_t)(MP + 4 * b + t) * 512 + h * 128;
        const v2u vw = *(const v2u*)(HV + rb + 4 * v4);
        const f32x4 vv = {__builtin_bit_cast(float, vw.x << 16), __builtin_bit_cast(float, vw.x & 0xffff0000u), __builtin_bit_cast(float, vw.y << 16), __builtin_bit_cast(float, vw.y & 0xffff0000u)};
        f32x4 po = {0.f, 0.f, 0.f, 0.f};
#pragma unroll
        for (int i = 0; i < 8; ++i) { const float f = ex2(HLF[rb + 8 * kq + i] * LOG2E_F), q = bf2f(HQ[rb + 8 * kq + i]); S[i] = S[i] * f + vv * (1.0f - f); po += S[i] * q; }
        *(LAS f32x4*)(OP + (t * 16 + kq) * 128 + 4 * v4) = po;
    }
    float* so = ohs + ((size_t)unit * 128 + 8 * kq) * 128 + 4 * v4;
#pragma unroll
    for (int i = 0; i < 8; ++i) *(f32x4*)(so + i * 128) = S[i];
    LDS_SYNC();
    const int t = tid >> 7, v = tid & 127; float o = 0.f;
#pragma unroll
    for (int q = 0; q < 16; ++q) o += OP[(t * 16 + q) * 128 + v];
    const float ps = wave_sum(o * o);
    if ((tid & 63) == 0) PS[wid] = ps;
    LDS_SYNC();
    const float rstd = rsqrtf((PS[2 * t] + PS[2 * t + 1]) * (1.0f / 128.0f) + EPSF);
    const size_t row = (size_t)(MP + 4 * b + t);
    MIX[row * 1024 + 512 + h * 128 + v] = (bf16)f2bf(o * rstd * bf2f(HG[row * 512 + h * 128 + v]));
    LDS_SYNC();
}

#ifdef DIAG_T9
__device__ __forceinline__ void hgrn_seq_unit(int bh, LAS unsigned char* lds, const float* HLF, const bf16* HQ, const bf16* HV, const bf16* HG, bf16* MIX) {
    const int tid = threadIdx.x, wid = tid >> 6, b = bh >> 2, h = bh & 3, v4 = tid & 31, kq = tid >> 5;
    LAS float* OP = (LAS float*)lds; LAS float* PS = (LAS float*)(lds + 32768);
    f32x4 S[8];
#pragma unroll
    for (int i = 0; i < 8; ++i) S[i] = (f32x4){0.f, 0.f, 0.f, 0.f};
    for (int g = 0; g < TP / 4; ++g) {
#pragma unroll
        for (int t = 0; t < 4; ++t) {
            const size_t rb = (size_t)(b * TP + 4 * g + t) * 512 + h * 128;
            const v2u vw = *(const v2u*)(HV + rb + 4 * v4);
            const f32x4 vv = {__builtin_bit_cast(float, vw.x << 16), __builtin_bit_cast(float, vw.x & 0xffff0000u), __builtin_bit_cast(float, vw.y << 16), __builtin_bit_cast(float, vw.y & 0xffff0000u)};
            f32x4 po = {0.f, 0.f, 0.f, 0.f};
#pragma unroll
            for (int i = 0; i < 8; ++i) { const float f = ex2(HLF[rb + 8 * kq + i] * LOG2E_F), q = bf2f(HQ[rb + 8 * kq + i]); S[i] = S[i] * f + vv * (1.0f - f); po += S[i] * q; }
            *(LAS f32x4*)(OP + (t * 16 + kq) * 128 + 4 * v4) = po;
        }
        LDS_SYNC();
        const int t = tid >> 7, v = tid & 127; float o = 0.f;
#pragma unroll
        for (int q = 0; q < 16; ++q) o += OP[(t * 16 + q) * 128 + v];
        const float ps = wave_sum(o * o);
        if ((tid & 63) == 0) PS[wid] = ps;
        LDS_SYNC();
        const float rstd = rsqrtf((PS[2 * t] + PS[2 * t + 1]) * (1.0f / 128.0f) + EPSF);
        const size_t row = (size_t)(b * TP + 4 * g + t);
        if (DIAG_SEL(4 * g + t)) MIX[row * 1024 + 512 + h * 128 + v] = (bf16)f2bf(o * rstd * bf2f(HG[row * 512 + h * 128 + v]));
        LDS_SYNC();
    }
}
#endif
namespace att {
constexpr int SLOT = 16384, NSLOT = 3, L_K = 0, L_V = NSLOT * SLOT, L_STG = 0, STG_BYTES = 17408;
static_assert(L_V + NSLOT * SLOT <= RING_BYTES && 4 * STG_BYTES <= L_V + NSLOT * SLOT, "attention LDS");
__device__ __forceinline__ void glds16(const void* gsrc, unsigned lds_dst) { unsigned keep;
    asm volatile("s_mov_b32 %0, m0\n\ts_mov_b32 m0, %2\n\ts_nop 0\n\tglobal_load_lds_dwordx4 %1, off\n\ts_mov_b32 m0, %0" : "=&s"(keep) : "v"(gsrc), "s"(lds_dst) : "memory"); }
__device__ __forceinline__ unsigned cvtpk_s(float lo, float hi) { return pg8::cvt_pk_bf16(lo, hi); }
__device__ __forceinline__ void attn_unit(int b, int h, int qb, const bf16* Q, const bf16* K, const bf16* V, bf16* MIX, LAS unsigned char* lds, const LAS float* BLh, float lam, LAS float* als) {
    const int tid = threadIdx.x, lane = tid & 63, r32 = lane & 31, hi = lane >> 5; const int wid = __builtin_amdgcn_readfirstlane(tid >> 6), map = wid >> 2, qw = wid & 3;
    const long rowbase = (long)b * TP; const int q0 = qb * 128;
    const bf16* Qw = Q + (rowbase + q0 + qw * 32) * 512 + h * 128 + map * 64;
    const bf16* Kh = K + rowbase * 512 + h * 128; const bf16* Vh = V + rowbase * 512 + h * 128;
    const unsigned lds0 = (unsigned)(uintptr_t)lds;
    const bf16* ksrc0 = Kh + (long)lane * 512 + (wid >> 3) * 64 + (wid & 7) * 8;
    const bf16* ksrc1 = Kh + (long)lane * 512 + 64 + (wid & 7) * 8;
    const bf16* vsrc0 = Vh + (long)(16 * (wid & 3) + (lane >> 2)) * 512 + (wid >> 2) * 32 + (lane & 3) * 8;
    const bf16* vsrc1 = Vh + (long)(16 * (wid & 3) + (lane >> 2)) * 512 + (2 + (wid >> 2)) * 32 + (lane & 3) * 8;
#define ADMA(t, slot) do { const long o_ = (long)(t) * 64 * 512; const unsigned s_ = (unsigned)(slot) * SLOT; \
        glds16(ksrc0 + o_, (unsigned)__builtin_amdgcn_readfirstlane(lds0 + L_K + s_ + wid * 1024)); glds16(ksrc1 + o_, (unsigned)__builtin_amdgcn_readfirstlane(lds0 + L_K + s_ + (wid + 8) * 1024)); \
        glds16(vsrc0 + o_, (unsigned)__builtin_amdgcn_readfirstlane(lds0 + L_V + s_ + wid * 1024)); glds16(vsrc1 + o_, (unsigned)__builtin_amdgcn_readfirstlane(lds0 + L_V + s_ + (wid + 8) * 1024)); } while (0)
    const int NT = 2 * qb + 2;
    bf16x8 qr[4];
#pragma unroll
    for (int d0 = 0; d0 < 4; ++d0) qr[d0] = *(const bf16x8*)(Qw + (long)r32 * 512 + d0 * 16 + hi * 8);
    asm volatile("s_waitcnt vmcnt(0)" ::: "memory");
    ADMA(0, 0); ADMA(1, 1);
    f32x16 o[4];
#pragma unroll
    for (int d = 0; d < 4; ++d)
#pragma unroll
        for (int r = 0; r < 16; ++r) o[d][r] = 0.f;
    float lsum = 0.f;
    const float cfar = BLh[127];
    const int qabs = q0 + qw * 32 + r32;
    int slot = 0;
    for (int t = 0; t < NT; ++t) {
        if (t + 1 < NT) asm volatile("s_waitcnt vmcnt(4) lgkmcnt(0)\n\ts_barrier" ::: "memory"); else asm volatile("s_waitcnt vmcnt(0) lgkmcnt(0)\n\ts_barrier" ::: "memory");
        if (t + 2 < NT) { const int s2 = slot == 0 ? 2 : slot - 1; ADMA(t + 2, s2); }
        const LAS unsigned char* kb = lds + L_K + slot * SLOT + map * 8192 + hi * 1024 + r32 * 16;
        const bool band = t >= NT - 4;
        f32x16 p0, p1; const float ci = band ? 0.f : cfar;
#pragma unroll
        for (int r = 0; r < 16; ++r) { p0[r] = ci; p1[r] = ci; }
#pragma unroll
        for (int d0 = 0; d0 < 4; ++d0) { const bf16x8 b0 = *(const LAS bf16x8*)(kb + d0 * 2048), b1 = *(const LAS bf16x8*)(kb + d0 * 2048 + 512); p0 = MFMA32(b0, qr[d0], p0); p1 = MFMA32(b1, qr[d0], p1); }
        if (band) {
            const int nb = qabs - 64 * t - 4 * hi;
            float bv0[16], bv1[16];
#pragma unroll
            for (int r = 0; r < 16; ++r) { const int n0 = nb - ((r & 3) + 8 * (r >> 2)), n1 = n0 - 32; bv0[r] = BLh[n0 > 127 ? 127 : (n0 < 0 ? 0 : n0)]; bv1[r] = BLh[n1 > 127 ? 127 : (n1 < 0 ? 0 : n1)]; }
            asm volatile("s_waitcnt lgkmcnt(0)" ::: "memory");
#pragma unroll
            for (int r = 0; r < 16; ++r) { const int n0 = nb - ((r & 3) + 8 * (r >> 2)), n1 = n0 - 32; p0[r] = n0 < 0 ? -INFINITY : p0[r] + bv0[r]; p1[r] = n1 < 0 ? -INFINITY : p1[r] + bv1[r]; }
        }
        float sacc = 0.f;
#pragma unroll
        for (int r = 0; r < 16; ++r) { p0[r] = ex2(p0[r]); p1[r] = ex2(p1[r]); sacc += p0[r] + p1[r]; }
        lsum += sacc;
        bf16x8 pa[4];
        { v4u w;
          w = (v4u){cvtpk_s(p0[0], p0[1]), cvtpk_s(p0[2], p0[3]), cvtpk_s(p0[4], p0[5]), cvtpk_s(p0[6], p0[7])}; pa[0] = __builtin_bit_cast(bf16x8, w);
          w = (v4u){cvtpk_s(p0[8], p0[9]), cvtpk_s(p0[10], p0[11]), cvtpk_s(p0[12], p0[13]), cvtpk_s(p0[14], p0[15])}; pa[1] = __builtin_bit_cast(bf16x8, w);
          w = (v4u){cvtpk_s(p1[0], p1[1]), cvtpk_s(p1[2], p1[3]), cvtpk_s(p1[4], p1[5]), cvtpk_s(p1[6], p1[7])}; pa[2] = __builtin_bit_cast(bf16x8, w);
          w = (v4u){cvtpk_s(p1[8], p1[9]), cvtpk_s(p1[10], p1[11]), cvtpk_s(p1[12], p1[13]), cvtpk_s(p1[14], p1[15])}; pa[3] = __builtin_bit_cast(bf16x8, w); }
        const int vb = (int)(lds0 + L_V + slot * SLOT) + ((lane >> 4) & 1) * 32 + (lane & 3) * 8 + (4 * hi + ((lane & 15) >> 2)) * 64;
#pragma unroll
        for (int d0 = 0; d0 < 4; ++d0) { s16x4 lo[4], hh[4];
#pragma unroll
            for (int ks = 0; ks < 4; ++ks) {
                asm volatile("ds_read_b64_tr_b16 %0,%1 offset:%c2" : "=&v"(lo[ks]) : "v"(vb), "i"(d0 * 4096 + ks * 1024) : "memory");
                asm volatile("ds_read_b64_tr_b16 %0,%1 offset:%c2" : "=&v"(hh[ks]) : "v"(vb), "i"(d0 * 4096 + ks * 1024 + 512) : "memory"); }
            asm volatile("s_waitcnt lgkmcnt(0)" ::: "memory"); __builtin_amdgcn_sched_barrier(0);
#pragma unroll
            for (int ks = 0; ks < 4; ++ks) { const bf16x8 vf = (bf16x8){lo[ks][0], lo[ks][1], lo[ks][2], lo[ks][3], hh[ks][0], hh[ks][1], hh[ks][2], hh[ks][3]}; o[d0] = MFMA32(pa[ks], vf, o[d0]); }
        }
        slot = slot == 2 ? 0 : slot + 1;
    }
#undef ADMA
    { auto rr = __builtin_amdgcn_permlane32_swap(__float_as_uint(lsum), __float_as_uint(lsum), false, false); lsum = __uint_as_float(rr[0]) + __uint_as_float(rr[1]); }
    LAS float* myl = als + wid * 32;
    if (hi == 0) myl[r32] = lsum;
    asm volatile("s_waitcnt vmcnt(0) lgkmcnt(0)\n\ts_barrier" ::: "memory");
    float rl[16];
#pragma unroll
    for (int r = 0; r < 16; ++r) rl[r] = __builtin_amdgcn_rcpf(myl[crow(r, hi)]);
    LAS float* stg = (LAS float*)(lds + L_STG + qw * STG_BYTES);
    if (map == 1) {
#pragma unroll
        for (int d = 0; d < 4; ++d)
#pragma unroll
            for (int r = 0; r < 16; ++r) stg[(d * 16 + r) * 64 + lane] = o[d][r] * rl[r];
    }
    asm volatile("s_waitcnt lgkmcnt(0)\n\ts_barrier" ::: "memory");
    if (map == 0) {
#pragma unroll
        for (int d = 0; d < 4; ++d)
#pragma unroll
            for (int r = 0; r < 16; ++r) o[d][r] = o[d][r] * rl[r] - lam * stg[(d * 16 + r) * 64 + lane];
        asm volatile("s_waitcnt lgkmcnt(0)" ::: "memory");
#pragma unroll
        for (int d = 0; d < 4; ++d)
#pragma unroll
            for (int r = 0; r < 16; ++r) stg[crow(r, hi) * 132 + d * 32 + r32] = o[d][r];
        asm volatile("s_waitcnt lgkmcnt(0)" ::: "memory");
        bf16* Mw = MIX + (rowbase + q0 + qw * 32) * 1024 + h * 128;
#pragma unroll
        for (int ps = 0; ps < 8; ++ps) { const int row = ps * 4 + (lane >> 4), seg = lane & 15;
            const f32x4 a = *(const LAS f32x4*)(stg + row * 132 + 8 * seg), c = *(const LAS f32x4*)(stg + row * 132 + 8 * seg + 4);
            float ss = (a[0] * a[0] + a[1] * a[1]) + (a[2] * a[2] + a[3] * a[3]) + (c[0] * c[0] + c[1] * c[1]) + (c[2] * c[2] + c[3] * c[3]);
            ss += __shfl_xor(ss, 1); ss += __shfl_xor(ss, 2); ss += __shfl_xor(ss, 4); ss += __shfl_xor(ss, 8);
            const float rstd = rsqrtf(ss * (1.0f / 128.0f) + EPSF);
            *(v4u*)(Mw + (long)row * 1024 + 8 * seg) = (v4u){cvtpk_s(a[0] * rstd, a[1] * rstd), cvtpk_s(a[2] * rstd, a[3] * rstd), cvtpk_s(c[0] * rstd, c[1] * rstd), cvtpk_s(c[2] * rstd, c[3] * rstd)}; }
    }
    asm volatile("s_waitcnt lgkmcnt(0)\n\ts_barrier" ::: "memory");
}
}
namespace dec {
typedef float f32x4 __attribute__((ext_vector_type(4)));
#define MFMA16(a, b, c) __builtin_amdgcn_mfma_f32_16x16x32_bf16((a), (b), (c), 0, 0, 0)
__device__ __forceinline__ bf16x8 cvt8(f32x4 a, f32x4 b) { v4u w = {pk2(a[0], a[1]), pk2(a[2], a[3]), pk2(b[0], b[1]), pk2(b[2], b[3])}; return __builtin_bit_cast(bf16x8, w); }
__device__ __forceinline__ void decode_unit(int b, const float* ck, const float* cv, const int* pt, const bf16* QB, const float* ksamp, const float* vsamp, bf16* MIX, LAS unsigned char* lds, const LAS float* BL, float lam) {
    const int tid = threadIdx.x, lane = tid & 63, n = lane & 15, q = lane >> 4; const int wid = __builtin_amdgcn_readfirstlane(tid >> 6), h = wid & 3, kh = wid >> 2;
    const LAS float* BLh = BL + h * 128;
    LAS bf16x8* qfl = (LAS bf16x8*)(lds + 40960 + wid * 4096) + lane;
#pragma unroll
    for (int mp = 0; mp < 2; ++mp)
#pragma unroll
        for (int ks = 0; ks < 2; ++ks) { const int tk = n - 4 * mp; const bool ok = tk >= 0 && tk < 4;
            const v4u w = ok ? *(const v4u*)(QB + (size_t)(MP + 4 * b + tk) * 512 + h * 128 + mp * 64 + 32 * ks + 8 * q) : (v4u){0u, 0u, 0u, 0u}; qfl[(mp * 2 + ks) * 64] = __builtin_bit_cast(bf16x8, w); }
    asm volatile("s_waitcnt lgkmcnt(0)" ::: "memory");
    const int tok = n & 3;
    f32x4 O[8];
#pragma unroll
    for (int c = 0; c < 8; ++c) O[c] = (f32x4){0.f, 0.f, 0.f, 0.f};
    float lsum = 0.f;
    const int NIT = kh == 0 ? 33 : 32;
    f32x4 kr[2][2][2][2], vr[8][2];
    const int vkey0 = 4 * q;
#define DEC_BASES(i_, KB_, VB_, K0_, NEW_) do { const bool nw_ = (i_) == 32; const int T_ = 2 * (i_) + kh; \
        if (!nw_) { const int phys_ = __builtin_amdgcn_readlane(ptv, T_ >> 2); const size_t ro_ = ((size_t)phys_ * PAGE + 32 * (T_ & 3)) * 512 + h * 128; KB_ = ck + ro_; VB_ = cv + ro_; K0_ = 32 * T_; } \
        else { const size_t ro_ = (size_t)(4 * b) * 512 + h * 128; KB_ = ksamp + ro_; VB_ = vsamp + ro_; K0_ = PAST; } NEW_ = nw_; } while (0)
#define DEC_LOADK(KB_, NEW_) do { _Pragma("unroll") for (int sub = 0; sub < 2; ++sub) { int key_ = 16 * sub + n; if (NEW_) key_ = key_ > 3 ? 3 : key_; const float* kp_ = (KB_) + (size_t)key_ * 512 + 8 * q; \
        _Pragma("unroll") for (int mp = 0; mp < 2; ++mp) _Pragma("unroll") for (int ks = 0; ks < 2; ++ks) { kr[sub][mp][ks][0] = *(const f32x4*)(kp_ + mp * 64 + 32 * ks); kr[sub][mp][ks][1] = *(const f32x4*)(kp_ + mp * 64 + 32 * ks + 4); } } } while (0)
#define DEC_LOADV(VB_, NEW_) do { _Pragma("unroll") for (int j = 0; j < 8; ++j) { int key_ = (j < 4) ? vkey0 + j : 16 + vkey0 + (j - 4); if (NEW_) key_ = key_ > 3 ? 3 : key_; \
        _Pragma("unroll") for (int hf = 0; hf < 2; ++hf) vr[j][hf] = *(const f32x4*)((VB_) + (size_t)key_ * 512 + 64 * hf + 4 * n); } } while (0)
    const int ptv = pt[b * NPAGES + (lane & 15)];
    const float* kbase; const float* vbase; int key0; bool isnew;
    DEC_BASES(0, kbase, vbase, key0, isnew);
    DEC_LOADK(kbase, isnew);
    for (int i = 0; i < NIT; ++i) {
        __builtin_amdgcn_sched_barrier(0);
        DEC_LOADV(vbase, isnew);
        __builtin_amdgcn_sched_barrier(0);
        f32x4 s[2];
#pragma unroll
        for (int sub = 0; sub < 2; ++sub) {
            s[sub] = (f32x4){0.f, 0.f, 0.f, 0.f};
#pragma unroll
            for (int mp = 0; mp < 2; ++mp)
#pragma unroll
                for (int ks = 0; ks < 2; ++ks) s[sub] = MFMA16(cvt8(kr[sub][mp][ks][0], kr[sub][mp][ks][1]), qfl[(mp * 2 + ks) * 64], s[sub]);
        }
        const int key0c = key0; const bool isnewc = isnew;
        __builtin_amdgcn_sched_barrier(0);
        const float* vb_cur = vbase;
        if (i + 1 < NIT) { DEC_BASES(i + 1, kbase, vbase, key0, isnew); DEC_LOADK(kbase, isnew); }
        __builtin_amdgcn_sched_barrier(0);
        (void)vb_cur;
        f32x4 p[2], bvs[2];
#pragma unroll
        for (int sub = 0; sub < 2; ++sub)
#pragma unroll
            for (int r = 0; r < 4; ++r) { const int dist = PAST + tok - (key0c + 16 * sub + 4 * q + r); bvs[sub][r] = BLh[dist > 127 ? 127 : (dist < 0 ? 0 : dist)]; }
        asm volatile("s_waitcnt lgkmcnt(0)" ::: "memory");
#pragma unroll
        for (int sub = 0; sub < 2; ++sub)
#pragma unroll
            for (int r = 0; r < 4; ++r) { const int kl = 16 * sub + 4 * q + r; const int dist = PAST + tok - (key0c + kl);
                bool ok = n < 8; if (isnewc) ok = ok && kl < 4 && dist >= 0;
                const float e = ex2(s[sub][r] + bvs[sub][r]); p[sub][r] = ok ? e : 0.f; }
        lsum += ((p[0][0] + p[0][1]) + (p[0][2] + p[0][3])) + ((p[1][0] + p[1][1]) + (p[1][2] + p[1][3]));
        const bf16x8 pf = cvt8(p[0], p[1]);
#pragma unroll
        for (int hf = 0; hf < 2; ++hf)
#pragma unroll
            for (int c = 0; c < 4; ++c) { const v4u w = {pk2(vr[0][hf][c], vr[1][hf][c]), pk2(vr[2][hf][c], vr[3][hf][c]), pk2(vr[4][hf][c], vr[5][hf][c]), pk2(vr[6][hf][c], vr[7][hf][c])};
                O[hf * 4 + c] = MFMA16(pf, __builtin_bit_cast(bf16x8, w), O[hf * 4 + c]); }
    }
#undef DEC_BASES
#undef DEC_LOADK
#undef DEC_LOADV
    lsum += __shfl_xor(lsum, 16); lsum += __shfl_xor(lsum, 32);
    LAS float* cb = (LAS float*)lds + h * (33 * 64);
    if (kh == 1) {
#pragma unroll
        for (int c = 0; c < 8; ++c)
#pragma unroll
            for (int r = 0; r < 4; ++r) cb[(c * 4 + r) * 64 + lane] = O[c][r];
        cb[32 * 64 + lane] = lsum;
    }
    LDS_SYNC();
    if (kh == 0) {
#pragma unroll
        for (int c = 0; c < 8; ++c)
#pragma unroll
            for (int r = 0; r < 4; ++r) O[c][r] += cb[(c * 4 + r) * 64 + lane];
        lsum += cb[32 * 64 + lane];
        LAS float* ls = (LAS float*)lds + 4 * 33 * 64 + h * 16;
        if (q == 0) ls[n] = lsum;
        asm volatile("s_waitcnt lgkmcnt(0)" ::: "memory");
        float y[8][4], ss[4] = {0.f, 0.f, 0.f, 0.f};
#pragma unroll
        for (int r = 0; r < 4; ++r) { const float rl0 = __builtin_amdgcn_rcpf(ls[r]), rl1 = __builtin_amdgcn_rcpf(ls[4 + r]);
#pragma unroll
            for (int c = 0; c < 8; ++c) { const float o1 = __shfl(O[c][r], (lane & 15) + 16); y[c][r] = O[c][r] * rl0 - lam * o1 * rl1; ss[r] += y[c][r] * y[c][r]; } }
#pragma unroll
        for (int r = 0; r < 4; ++r) { ss[r] += __shfl_xor(ss[r], 1); ss[r] += __shfl_xor(ss[r], 2); ss[r] += __shfl_xor(ss[r], 4); ss[r] += __shfl_xor(ss[r], 8); }
        if (q == 0) {
#pragma unroll
            for (int r = 0; r < 4; ++r) { const float rstd = rsqrtf(ss[r] * (1.0f / 128.0f) + EPSF); bf16* mo = MIX + (size_t)(MP + 4 * b + r) * 1024 + h * 128 + 4 * n;
#pragma unroll
                for (int hf = 0; hf < 2; ++hf) *(v2u*)(mo + 64 * hf) = (v2u){pk2(y[hf * 4][r] * rstd, y[hf * 4 + 1][r] * rstd), pk2(y[hf * 4 + 2][r] * rstd, y[hf * 4 + 3][r] * rstd)}; }
        }
    }
    LDS_SYNC();
}
}
#ifndef NDEC_CU
#define NDEC_CU 48
#endif
#ifndef REP_Q
#define REP_Q 1
#endif
#ifndef REP_DEC
#define REP_DEC 1
#endif
#ifndef REP_ATT
#define REP_ATT 1
#endif
#ifndef REP_P1
#define REP_P1 1
#endif
#ifndef REP_P6
#define REP_P6 1
#endif
struct Args { PIn in; float* out; unsigned char* ws; };
typedef __attribute__((address_space(4))) const Args* KArgs;
__device__ __forceinline__ void p0_prologue(KArgs A, unsigned char* ws, LAS unsigned char* lds, int vcu, int G, int wave, int lane) {
    LAS float* scr = (LAS float*)(lds + RING_OFF + wave * 16384);
    const int gw = vcu * NWAVES + wave, NGW = G * NWAVES;
    bf16* WIN = (bf16*)(ws + WS_WIN); bf16* WOUT = (bf16*)(ws + WS_WOUT); bf16* WGU = (bf16*)(ws + WS_WGU); bf16* WDN = (bf16*)(ws + WS_WDN);
    constexpr int I_IN = 16 * 112, I_OUT = 16 * 32, I_G = 16 * 88, I_D = 44 * 32, NITEMS = I_IN + I_OUT + 2 * I_G + I_D;
    for (int it = gw; it < NITEMS; it += NGW) {
        int r = it;
        if (r < I_IN) { const int kb = r / 112, nb = r % 112, pn = nb >> 3, cbk = nb & 7; const float* g1 = A->in.g1;
            p0_transpose_item(A->in.win, DM, NIN, WIN, kb, nb, 256 * pn + 128 * (cbk & 1) + 32 * (cbk >> 1), scr, lane, [g1](int k) { return g1[k]; }); continue; } r -= I_IN;
        if (r < I_OUT) { const int kb = r / 32, nb = r % 32; const float* sg = A->in.subg; const float* og = A->in.ong;
            p0_transpose_item(A->in.wout, DM, DM, WOUT, kb, nb, 32 * nb, scr, lane, [sg, og](int k) { return k < 512 ? 0.8f * sg[k & 127] : og[k & 127]; }); continue; } r -= I_OUT;
        if (r < I_G) { const int kb = r / 88, nb = r % 88; const float* g2 = A->in.g2;
            p0_transpose_item(A->in.wg, DM, DFF, WGU, kb, nb, 256 * (nb >> 2) + 32 * (nb & 3), scr, lane, [g2](int k) { return g2[k]; }); continue; } r -= I_G;
        if (r < I_G) { const int kb = r / 88, nb = r % 88; const float* g2 = A->in.g2;
            p0_transpose_item(A->in.wu, DM, DFF, WGU, kb, nb, 256 * (nb >> 2) + 128 + 32 * (nb & 3), scr, lane, [g2](int k) { return g2[k]; }); continue; } r -= I_G;
        { const int kb = r / 32, nb = r % 32; p0_transpose_item(A->in.wd, DFF, DM, WDN, kb, nb, 32 * nb, scr, lane, [](int) { return 1.0f; }); }
    }
    bf16* XB = (bf16*)(ws + WS_XB); float* RSTD1 = (float*)(ws + WS_RSTD1);
    for (int m = gw; m < MALL; m += NGW) {
        const float* xrow = m < MP ? A->in.xp + (size_t)m * DM : A->in.xs + (size_t)(m - MP) * DM;
        const GAS f32x4* xr = (const GAS f32x4*)xrow + lane; f32x4 v[4]; float s = 0.f;
#pragma unroll
        for (int j = 0; j < 4; ++j) { v[j] = xr[64 * j]; s += (v[j][0] * v[j][0] + v[j][1] * v[j][1]) + (v[j][2] * v[j][2] + v[j][3] * v[j][3]); }
        s = wave_sum(s);
        GAS v2u* o8 = (GAS v2u*)(XB + (size_t)m * DM) + lane;
#pragma unroll
        for (int j = 0; j < 4; ++j) o8[64 * j] = (v2u){pk2(v[j][0], v[j][1]), pk2(v[j][2], v[j][3])};
        if (lane == 0) RSTD1[m] = rsqrtf(s * (1.0f / DM) + EPSF);
    }
}
__device__ __forceinline__ void conv_fixup(int pm, const float* cwp, const float* cbp, unsigned char* ws, int tid) {
    const float* HA = (const float*)(ws + WS_HALOA); const float* HU = (const float*)(ws + WS_HALOU); const float* LA = (const float*)(ws + WS_LASTA); bf16* G = (bf16*)(ws + WS_G);
    const bool first = (pm & 31) == 0;
    for (int e = tid; e < 2 * DFF; e += NWAVES * 64) {
        const int i = e >= DFF, c = e - i * DFF;
        const float a = HA[(size_t)(pm * 2 + i) * DFF + c], u = HU[(size_t)(pm * 2 + i) * DFF + c];
        float p1, p2;
        if (i == 0) { p1 = first ? 0.f : LA[(size_t)((pm - 1) * 2 + 1) * DFF + c]; p2 = first ? 0.f : LA[(size_t)((pm - 1) * 2) * DFF + c]; }
        else { p1 = HA[(size_t)(pm * 2) * DFF + c]; p2 = first ? 0.f : LA[(size_t)((pm - 1) * 2 + 1) * DFF + c]; }
        const float cc = cbp[c] + cwp[c] * p2 + cwp[DFF + c] * p1 + cwp[2 * DFF + c] * a;
        G[(size_t)(pm * 256 + i) * DFF + c] = (bf16)f2bf(cc * sigm_f(cc) * u);
    }
}
__device__ __forceinline__ KArgs kargs() { KArgs p = (KArgs)__builtin_amdgcn_kernarg_segment_ptr(); asm volatile("" : "+s"(p)); return p; }
__global__ void __launch_bounds__(NWAVES * 64, 2) fwd(Args args_unused) {
    extern __shared__ __attribute__((aligned(16))) unsigned char lds_raw[];
    LAS unsigned char* lds = (LAS unsigned char*)lds_raw;
    const int tid = threadIdx.x, lane = tid & 63, wave = __builtin_amdgcn_readfirstlane(tid >> 6);
    const int G = gridDim.x, bx = blockIdx.x, vcu = (G % 8 == 0) ? (bx % 8) * (G / 8) + bx / 8 : bx;
    for (int u = tid; u < (LDS_BYTES - LDSCTL_OFF) / 4; u += NWAVES * 64) ((LAS unsigned*)(lds + LDSCTL_OFF))[u] = 0u;
    __syncthreads();
    volatile LAS unsigned* MISC = (volatile LAS unsigned*)(lds + MISC_OFF);
    XcdBarrier bar;
    { KArgs A = kargs(); bar = xcd_barrier_post((unsigned*)(A->ws + WS_CTL) + CW_BAR, MISC + 8); }
    LAS float* BL = (LAS float*)(lds + BL_OFF); LAS float* SCAL = (LAS float*)(lds + SCAL_OFF);
    { KArgs A = kargs(); const float* relb = A->in.relb; const float* lqk = A->in.lqk;
      const int h = tid >> 7, n = tid & 127; int bk = n;
      if (n >= 16) { bk = 16 + (int)(logf((float)n * (1.0f / 16.0f)) / logf(8.0f) * 16.0f); bk = bk > 31 ? 31 : bk; }
      BL[h * 128 + n] = relb[bk * 4 + h] * LOG2E_F;
      if (tid < 64) { float a = lqk[tid] * lqk[64 + tid], c = lqk[128 + tid] * lqk[192 + tid]; a = wave_sum(a); c = wave_sum(c); if (tid == 0) SCAL[0] = expf(a) - expf(c) + 0.2f; } }
    __syncthreads();

#ifdef DIAG_TS
#define TSTAMP(i) do { if (bx == 0 && tid == 0) ((volatile LAS unsigned*)(lds + MISC_OFF))[16 + (i)] = (unsigned)__builtin_amdgcn_s_memrealtime(); } while (0)
#else
#define TSTAMP(i) do {} while (0)
#endif
    TSTAMP(0);
    { KArgs A = kargs(); p0_prologue(A, A->ws, lds, vcu, G, wave, lane); }
    xcd_barrier(bar);
    TSTAMP(1);
    { KArgs A = kargs(); unsigned char* ws = A->ws; float* out = A->out;
      pg8::Gemm g{(const bf16*)(ws + WS_XB), (const bf16*)(ws + WS_WIN), MALL, NIN, DM, DM}; pg8::StaticOrder S; S.init(MALL, NIN, G, bx);
      pg8::EpiIn E{(bf16*)(ws + WS_QB), (float*)(ws + WS_HLF), out + O_KP, out + O_KS, (const float*)(ws + WS_RSTD1), A->in.gqk, A->in.hlb};
      for (int rep_ = 0; rep_ < REP_P1; ++rep_) pg8::gemm_phase<pg8::EpiIn, pg8::StaticOrder, PG8_ALIGN, PG8_SP2>(lds + RING_OFF, g, S, E); }
    xcd_barrier(bar);
    TSTAMP(2);
    { KArgs A = kargs(); unsigned char* ws = A->ws;
      for (int u = vcu; u < 256; u += G) hgrn_unit<false>(u, lds, (const float*)(ws + WS_HLF), (const bf16*)(ws + WS_HQ), (const bf16*)(ws + WS_HV), (const bf16*)(ws + WS_HG), (bf16*)(ws + WS_MIX), (float*)(ws + WS_UBUF), (float*)(ws + WS_DTOT), (const float*)(ws + WS_SST)); }
    xcd_barrier(bar);
    TSTAMP(3);
    { KArgs A = kargs(); unsigned char* ws = A->ws;
      hgrn_scan(vcu * (NWAVES * 64) + tid, G * NWAVES * 64, (const float*)(ws + WS_UBUF), (const float*)(ws + WS_DTOT), (float*)(ws + WS_SST), A->out + O_HP); }
    xcd_barrier(bar);
    TSTAMP(4);
    { KArgs A = kargs(); unsigned char* ws = A->ws;
      for (int u = vcu; u < 256; u += G) hgrn_unit<true>(u, lds, (const float*)(ws + WS_HLF), (const bf16*)(ws + WS_HQ), (const bf16*)(ws + WS_HV), (const bf16*)(ws + WS_HG), (bf16*)(ws + WS_MIX), (float*)(ws + WS_UBUF), (float*)(ws + WS_DTOT), (const float*)(ws + WS_SST)); }
#ifdef DIAG_T9
    { KArgs A = kargs(); unsigned char* ws = A->ws;
      for (int u = vcu; u < 8; u += G) hgrn_seq_unit(u, lds, (const float*)(ws + WS_HLF), (const bf16*)(ws + WS_HQ), (const bf16*)(ws + WS_HV), (const bf16*)(ws + WS_HG), (bf16*)(ws + WS_MIX)); }
#endif
    { KArgs A = kargs(); unsigned char* ws = A->ws;
      for (int u = vcu; u < NBS * 4; u += G) hgrn_sample_unit(u, lds, A->in.sh, (const float*)(ws + WS_HLF), (const bf16*)(ws + WS_HQ), (const bf16*)(ws + WS_HV), (const bf16*)(ws + WS_HG), (bf16*)(ws + WS_MIX), A->out + O_HS); }
    TSTAMP(8);
    { KArgs A = kargs(); unsigned char* ws = A->ws; const float lam = SCAL[0];
      const bf16* QB = (const bf16*)(ws + WS_QB); const bf16* KB = (const bf16*)(ws + WS_KB); const bf16* VB = (const bf16*)(ws + WS_VB); bf16* MIX = (bf16*)(ws + WS_MIX);
      gu32* qd = (gu32*)(ws + WS_CTL) + CW_QDEC; gu32* qa = (gu32*)(ws + WS_CTL) + CW_QATT;
      volatile LAS unsigned* qs = (volatile LAS unsigned*)(lds + MISC_OFF) + 12;
      int mode = (bx >> 3) < (NDEC_CU / 8) ? 0 : 1, done = 0;
      for (;;) {
        if (tid == 0) qs[0] = __hip_atomic_fetch_add(mode == 0 ? qd : qa, 1u, RLX_AGENT);
        LDS_SYNC(); const int i = __builtin_amdgcn_readfirstlane((int)qs[0]); LDS_SYNC();
        if (i >= (mode == 0 ? NBS : 512) * REP_Q) { if (++done == 2) break; mode ^= 1; continue; }
        if (mode == 0) dec::decode_unit(i % NBS, A->in.ck, A->in.cv, A->in.pt, QB, A->out + O_KS, A->out + O_VS, MIX, lds, BL, lam);
        else { const int bh = i & 7, qb = 63 - ((i >> 3) & 63); att::attn_unit(bh >> 2, bh & 3, qb, QB, KB, VB, MIX, lds, BL + (bh & 3) * 128, lam, (LAS float*)(lds + ALS_OFF)); }
      } }
    TSTAMP(9);
    xcd_barrier(bar);
    TSTAMP(5);
    { KArgs A = kargs(); unsigned char* ws = A->ws; float* out = A->out;
      pg8::Gemm g{(const bf16*)(ws + WS_MIX), (const bf16*)(ws + WS_WOUT), MALL, DM, DM, DM}; pg8::StaticOrder S; S.init(MALL, DM, G, bx);
      pg8::EpiOut E{A->in.xp, A->in.xs, out + O_YP, out + O_YS, (bf16*)(ws + WS_X1B), (float*)(ws + WS_SSQP)};
      pg8::gemm_phase<pg8::EpiOut, pg8::StaticOrder, PG8_ALIGN, PG8_SP2>(lds + RING_OFF, g, S, E); }
    xcd_barrier(bar);
    TSTAMP(6);
    { KArgs A = kargs(); unsigned char* ws = A->ws; float* out = A->out;
      pg8::Gemm g{(const bf16*)(ws + WS_X1B), (const bf16*)(ws + WS_WGU), MALL, 2 * DFF, DM, DM}; pg8::StaticOrder S; S.init(MALL, 2 * DFF, G, bx);
      pg8::EpiGU E{(bf16*)(ws + WS_G), (const float*)(ws + WS_SSQP), A->in.cw, A->in.cb, A->in.sconv, (float*)(ws + WS_HALOA), (float*)(ws + WS_HALOU), (float*)(ws + WS_LASTA), out + O_CP, out + O_CS, (PG8_LAS float*)(lds + XCH_OFF)};
      for (int rep_ = 0; rep_ < REP_P6; ++rep_) pg8::gemm_phase<pg8::EpiGU, pg8::StaticOrder, true, PG8_SP2>(lds + RING_OFF, g, S, E); }
    xcd_barrier(bar);
    TSTAMP(7);
    { KArgs A = kargs(); unsigned char* ws = A->ws; float* out = A->out;
      pg8::Gemm g{(const bf16*)(ws + WS_G), (const bf16*)(ws + WS_WDN), MALL, DM, DFF, DFF};
      pg8::DownOrder S; S.S0.init(MP, DM, G, bx); S.c = bx; S.nsplit = 11; S.klen = 256;
      { const float* cwp = A->in.cw; const float* cbp = A->in.cb; pg8::Unit u; if (S.S0.next(0, u)) conv_fixup(u.pm, cwp, cbp, ws, tid); }
      asm volatile("s_waitcnt vmcnt(0)" ::: "memory"); __syncthreads();
      pg8::EpiDown E{out + O_YP, out + O_YS, (float*)(ws + WS_PART)};
      pg8::gemm_phase<pg8::EpiDown, pg8::DownOrder, PG8_ALIGN, PG8_SP2>(lds + RING_OFF, g, S, E);
    }
    xcd_barrier(bar);
    { KArgs A = kargs(); const float* part = (const float*)(A->ws + WS_PART); float* ys = A->out + O_YS;
      for (int e4 = (vcu * (NWAVES * 64) + tid); e4 < MS * DM / 4; e4 += G * NWAVES * 64) {
        f32x4 s = *(const f32x4*)(ys + (size_t)e4 * 4);
#pragma unroll
        for (int p = 0; p < 11; ++p) s += *(const f32x4*)(part + (size_t)p * MS * DM + (size_t)e4 * 4);
        *(f32x4*)(ys + (size_t)e4 * 4) = s; }
    }
}

extern "C" void kernel_launch(void* const* d_in, const int* in_sizes, int n_in, void* d_out, int out_size, void* d_ws, size_t ws_size, hipStream_t stream) {
    static int grid = 0;
    if (grid == 0) {
        if (n_in != 22 || out_size != (int)O_END || ws_size < WS_END) { fprintf(stderr, "kernel_launch: unexpected shapes: n_in %d out %d ws %zu\n", n_in, out_size, ws_size); grid = -1; return; }
        int dev = 0, cus = 0, per_cu = 0;
        if (hipGetDevice(&dev) != hipSuccess || hipDeviceGetAttribute(&cus, hipDeviceAttributeMultiprocessorCount, dev) != hipSuccess) { grid = -1; return; }
        if (hipFuncSetAttribute((const void*)fwd, hipFuncAttributeMaxDynamicSharedMemorySize, LDS_BYTES) != hipSuccess) { fprintf(stderr, "kernel_launch: hipFuncSetAttribute failed\n"); grid = -1; return; }
        if (hipOccupancyMaxActiveBlocksPerMultiprocessor(&per_cu, (const void*)fwd, NWAVES * 64, LDS_BYTES) != hipSuccess || per_cu < 1) fprintf(stderr, "kernel_launch: occupancy query says %d\n", per_cu);
        (void)hipGetLastError();
        grid = cus;
    }
    if (grid < 0) return;
    if (hipMemsetAsync((char*)d_ws + WS_CTL, 0, CTL_ZERO_BYTES, stream) != hipSuccess) return;
    Args a{};
    const void** pp = (const void**)&a.in;
    for (int i = 0; i < 22; ++i) pp[i] = d_in[i];
    a.out = (float*)d_out; a.ws = (unsigned char*)d_ws;
    hipLaunchKernelGGL(fwd, dim3(grid), dim3(NWAVES * 64), LDS_BYTES, stream, a);
}
```

```cpp
#include <hip/hip_runtime.h>
#include <hip/hip_bf16.h>
#include <cstdio>
#include <cstdint>
#include <cmath>
namespace pg8 {
#define PG8_LAS __attribute__((address_space(3)))
typedef unsigned short bf16_t;
typedef short bf16x8 __attribute__((ext_vector_type(8)));
typedef float f32x4 __attribute__((ext_vector_type(4)));
typedef unsigned u32x4 __attribute__((ext_vector_type(4)));
constexpr int BM = 256, BK = 64, HALF = 128, HTB = HALF * BK * 2  , STAGE_BYTES = 8 * HTB, NXCD = 8, WGM = 8;

__host__ __device__ __forceinline__ int lds_byte(int r, int c) { const int st = (r >> 4) * 2 + (c >> 5), rr = r & 15, cc = c & 31, ob = rr * 64 + cc * 2; return st * 1024 + (ob ^ (((ob >> 9) & 1) << 5)); }
__host__ __device__ __forceinline__ void stage_rc(int b, int& R, int& C) { const int st = b / 1024, sb = b % 1024, swz = sb ^ (((sb >> 9) & 1) << 5); R = (st >> 1) * 16 + swz / 64; C = (st & 1) * 32 + (swz % 64) / 2; }
__host__ __device__ __forceinline__ int perm32(int rho) { const int n = rho >> 4, i = rho & 15; return 8 * (i >> 2) + 4 * n + (i & 3); }

struct Unit { int pm, pn, kb, nt; };
struct Gemm { const bf16_t* A; const bf16_t* Bt; int M, N, K, ldk; };

struct StaticOrder {
    int nM, nN, nwg, G, c;
    __host__ __device__ void init(int M, int N, int G_, int c_) { nM = M / BM; nN = N / BM; nwg = nM * nN; G = G_; c = c_; }
    __host__ __device__ bool next(int i, Unit& u) const {
        const long L = (long)i * G + c; if (L >= nwg) return false;
        int wgid = (int)L; { const int q = nwg / NXCD, r = nwg % NXCD, xcd = wgid % NXCD, off = wgid / NXCD; wgid = (xcd < r ? xcd * (q + 1) : r * (q + 1) + (xcd - r) * q) + off; }
        const int nig = WGM * nN, gid = wgid / nig, fm = gid * WGM, gsz = (nM - fm) < WGM ? (nM - fm) : WGM;
        u.pm = fm + ((wgid % nig) % gsz); u.pn = (wgid % nig) / gsz; u.kb = 0; u.nt = 0; return true;
    }
    __device__ __forceinline__ void a_ready(const Unit&) const {}
    __device__ __forceinline__ void done(const Unit&) const {}
};


struct DownOrder {
    StaticOrder S0; int c, nsplit, klen;
    __device__ bool next(int i, Unit& u) const { const bool hp = c < 8 * nsplit;
        if (hp && i == 0) { const int tile = c % 8, p = c / 8; u.pm = 64 + (tile >> 2); u.pn = tile & 3; u.kb = p * klen * 2; u.nt = klen / BK; return true; }
        if (i == (hp ? 1 : 0)) return S0.next(0, u);
        return false; }
    __device__ __forceinline__ void a_ready(const Unit&) const {}
    __device__ __forceinline__ void done(const Unit&) const {}
};
typedef float f32x2_t __attribute__((ext_vector_type(2))); typedef __bf16 bf16x2_t __attribute__((ext_vector_type(2)));
__device__ __forceinline__ unsigned cvt_pk_bf16(float lo, float hi) { f32x2_t v = {lo, hi}; bf16x2_t b = __builtin_convertvector(v, bf16x2_t); return __builtin_bit_cast(unsigned, b); }
typedef float f32x2 __attribute__((ext_vector_type(2)));
constexpr int MPR = 16384;
constexpr float EPS = 1e-6f, LOG2E = 1.4426950408889634f, QSCALE = 0.125f * 1.4426950408889634f;
__device__ __forceinline__ float sigm(float x) { return __builtin_amdgcn_rcpf(1.0f + __builtin_amdgcn_exp2f(-x * LOG2E)); }
__device__ __forceinline__ float dot4(f32x4 a) { return (a[0] * a[0] + a[1] * a[1]) + (a[2] * a[2] + a[3] * a[3]); }
typedef unsigned u32x2 __attribute__((ext_vector_type(2)));
__device__ __forceinline__ u32x4 pack8(f32x4 a, f32x4 b) { u32x4 w; w.x = cvt_pk_bf16(a[0], a[1]); w.y = cvt_pk_bf16(a[2], a[3]); w.z = cvt_pk_bf16(b[0], b[1]); w.w = cvt_pk_bf16(b[2], b[3]); return w; }

struct EpiIn {
    static constexpr bool PERM = true, AFTER_DRAIN = false;
    bf16_t* QB; float* HLF;
    static constexpr size_t BSTRIDE = (size_t)17 * 1024 * 1024 / 2; float *okp, *oks;   const float* rstd1; const float* gqk; const float* hlb;
    __device__ __forceinline__ void operator()(const f32x4 (&acc)[2][2][4][2], const Unit& u, int wr, int wc, int fr, int fq) const {
        const int type = u.pn >> 1;
        const int cl = (u.pn & 1) * 256 + wc * 64 + 8 * fq;
        const int row0 = u.pm * BM + wr * 64 + fr;
        float* const kvo = u.pm < 64 ? okp + (size_t)row0 * 512 : oks + (size_t)(row0 - MPR) * 512;
        const size_t vofs = u.pm < 64 ? (size_t)8388608 : (size_t)262144;
        float rs[2][4];
#pragma unroll
        for (int ai = 0; ai < 2; ++ai)
#pragma unroll
            for (int m = 0; m < 4; ++m) rs[ai][m] = rstd1[row0 + ai * HALF + m * 16];
        asm volatile("" : "+v"(rs[0][0]), "+v"(rs[0][1]), "+v"(rs[0][2]), "+v"(rs[0][3]), "+v"(rs[1][0]), "+v"(rs[1][1]), "+v"(rs[1][2]), "+v"(rs[1][3]));
        if (type <= 1) {
            const float* g = gqk + type * 128 + (wc & 1) * 64 + 8 * fq;
            f32x4 gv[2][2];
#pragma unroll
            for (int bj = 0; bj < 2; ++bj)
#pragma unroll
                for (int n = 0; n < 2; ++n) gv[bj][n] = *(const f32x4*)(g + 32 * bj + 4 * n);
            const float sc = type == 0 ? QSCALE : 1.0f;
#pragma unroll
            for (int ai = 0; ai < 2; ++ai)
#pragma unroll
                for (int m = 0; m < 4; ++m) {
                    const int row = row0 + ai * HALF + m * 16; f32x4 v[2][2]; float ss = 0.f;
#pragma unroll
                    for (int bj = 0; bj < 2; ++bj)
#pragma unroll
                        for (int n = 0; n < 2; ++n) { v[bj][n] = acc[ai][bj][m][n] * rs[ai][m]; ss += dot4(v[bj][n]); }
                    ss += __shfl_xor(ss, 16); ss += __shfl_xor(ss, 32);
                    const float rn = rsqrtf(ss * (1.0f / 64.0f) + EPS);
#pragma unroll
                    for (int bj = 0; bj < 2; ++bj) {
                        const f32x4 a = v[bj][0] * rn * gv[bj][0], b = v[bj][1] * rn * gv[bj][1];
                        if (type == 1) { float* ko = kvo + (size_t)(ai * HALF + m * 16) * 512 + cl + 32 * bj; *(f32x4*)ko = a; *(f32x4*)(ko + 4) = b; }
                        *(u32x4*)(QB + (size_t)type * BSTRIDE + (size_t)row * 512 + cl + 32 * bj) = pack8(a * sc, b * sc);
                    }
                }
        } else if (type == 4) {
            f32x4 lb[2][2];
#pragma unroll
            for (int bj = 0; bj < 2; ++bj)
#pragma unroll
                for (int n = 0; n < 2; ++n) { const f32x4 a = *(const f32x4*)(hlb + cl + 32 * bj + 4 * n), b = *(const f32x4*)(hlb + 512 + cl + 32 * bj + 4 * n);
#pragma unroll
                    for (int j = 0; j < 4; ++j) lb[bj][n][j] = sigm(a[j] - b[j]); }
#pragma unroll
            for (int ai = 0; ai < 2; ++ai)
#pragma unroll
                for (int m = 0; m < 4; ++m) {
                    const int row = row0 + ai * HALF + m * 16;
#pragma unroll
                    for (int bj = 0; bj < 2; ++bj)
#pragma unroll
                        for (int n = 0; n < 2; ++n) { f32x4 o;
#pragma unroll
                            for (int j = 0; j < 4; ++j) { const float z = acc[ai][bj][m][n][j] * rs[ai][m]; const float f = lb[bj][n][j] + (1.0f - lb[bj][n][j]) * sigm(z); o[j] = logf(f); }
                            *(f32x4*)(HLF + (size_t)row * 512 + cl + 32 * bj + 4 * n) = o; }
                }
        } else {
            bf16_t* dst = QB + (size_t)(type - (type > 4 ? 1 : 0)) * BSTRIDE;
#pragma unroll
            for (int ai = 0; ai < 2; ++ai)
#pragma unroll
                for (int m = 0; m < 4; ++m) {
                    const int row = row0 + ai * HALF + m * 16;
#pragma unroll
                    for (int bj = 0; bj < 2; ++bj) {
                        f32x4 a = acc[ai][bj][m][0] * rs[ai][m], b = acc[ai][bj][m][1] * rs[ai][m];
                        if (type == 2) { float* vo = kvo + vofs + (size_t)(ai * HALF + m * 16) * 512 + cl + 32 * bj; *(f32x4*)vo = a; *(f32x4*)(vo + 4) = b; }
                        if (type == 6) {
#pragma unroll
                            for (int j = 0; j < 4; ++j) { a[j] = a[j] * sigm(a[j]); b[j] = b[j] * sigm(b[j]); } }
                        *(u32x4*)(dst + (size_t)row * 512 + cl + 32 * bj) = pack8(a, b);
                    }
                }
        }
    }
};

struct EpiOut {
    static constexpr bool PERM = true, AFTER_DRAIN = false;
    const float *xp, *xs; float *yp, *ys; bf16_t* X1B; float* SSQP;
    __device__ __forceinline__ void operator()(const f32x4 (&acc)[2][2][4][2], const Unit& u, int wr, int wc, int fr, int fq) const {
        const int row0 = u.pm * BM + wr * 64 + fr, col0 = u.pn * BM + wc * 32 + 8 * fq;
        const float* const xb = u.pm < 64 ? xp + (size_t)row0 * 1024 : xs + (size_t)(row0 - MPR) * 1024; float* const yb = u.pm < 64 ? yp + (size_t)row0 * 1024 : ys + (size_t)(row0 - MPR) * 1024;
#pragma unroll
        for (int ai = 0; ai < 2; ++ai)
#pragma unroll
            for (int m = 0; m < 4; ++m) {
                const int row = row0 + ai * HALF + m * 16;
                const float* xin = xb + (size_t)(ai * HALF + m * 16) * 1024;
                float* yo = yb + (size_t)(ai * HALF + m * 16) * 1024;
                float ss = 0.f;
#pragma unroll
                for (int bj = 0; bj < 2; ++bj) { const int col = col0 + bj * HALF;
                    const f32x4 a = *(const f32x4*)(xin + col) + acc[ai][bj][m][0], b = *(const f32x4*)(xin + col + 4) + acc[ai][bj][m][1];
                    *(f32x4*)(yo + col) = a; *(f32x4*)(yo + col + 4) = b; ss += dot4(a) + dot4(b);
                    *(u32x4*)(X1B + (size_t)row * 1024 + col) = pack8(a, b); }
                ss += __shfl_xor(ss, 16); ss += __shfl_xor(ss, 32);
                if (fq == 0) SSQP[(size_t)row * 16 + u.pn * 4 + wc] = ss;
            }
    }
};

struct EpiNull { static constexpr bool PERM = true, AFTER_DRAIN = false;
    __device__ __forceinline__ void operator()(const f32x4 (&acc)[2][2][4][2], const Unit& u, int wr, int wc, int fr, int fq) const { asm volatile("" :: "v"(acc[0][0][0][0]), "v"(acc[1][1][3][1])); } };
struct EpiDown {
    static constexpr bool PERM = true, AFTER_DRAIN = false;
    float *yp, *ys, *part;
    __device__ __forceinline__ void operator()(const f32x4 (&acc)[2][2][4][2], const Unit& u, int wr, int wc, int fr, int fq) const {
        const int row0 = u.pm * BM + wr * 64 + fr, col0 = u.pn * BM + wc * 32 + 8 * fq;
        float* const yb = u.pm < 64 ? yp + (size_t)row0 * 1024 : ys + (size_t)(row0 - MPR) * 1024;
#pragma unroll
        for (int ai = 0; ai < 2; ++ai)
#pragma unroll
            for (int m = 0; m < 4; ++m) {
                float* yo = yb + (size_t)(ai * HALF + m * 16) * 1024;
#pragma unroll
                for (int bj = 0; bj < 2; ++bj) { float* p = yo + col0 + bj * HALF;
                    if (u.pm >= 64) { float* pp = part + ((size_t)(u.kb >> 9) * 512 + (row0 - MPR + ai * HALF + m * 16)) * 1024 + col0 + bj * HALF;
                        *(f32x4*)pp = acc[ai][bj][m][0]; *(f32x4*)(pp + 4) = acc[ai][bj][m][1]; continue; }
                    f32x4 a = *(const f32x4*)p + acc[ai][bj][m][0], b = *(const f32x4*)(p + 4) + acc[ai][bj][m][1];
                    *(f32x4*)p = a; *(f32x4*)(p + 4) = b; }
            }
    }
};

struct EpiGU {
    static constexpr bool PERM = true, AFTER_DRAIN = false;
    bf16_t* G; const float* SSQP; const float *cw, *cb, *sconv; float *HALO_A, *HALO_U, *LASTA, *ocp, *ocs; PG8_LAS float* xch;
    __device__ __forceinline__ void operator()(const f32x4 (&acc)[2][2][4][2], const Unit& u, int wr, int wc, int fr, int fq) const {
        const int colt = u.pn * 128 + 32 * wc + 8 * fq;
        const int row0 = u.pm * BM + wr * 64 + fr;
        float rs[2][4];
#pragma unroll
        for (int ai = 0; ai < 2; ++ai)
#pragma unroll
            for (int m = 0; m < 4; ++m) { const f32x4* p = (const f32x4*)(SSQP + (size_t)(row0 + ai * HALF + m * 16) * 16); const f32x4 s = (p[0] + p[1]) + (p[2] + p[3]);
                rs[ai][m] = rsqrtf(((s[0] + s[1]) + (s[2] + s[3])) * (1.0f / 1024.0f) + EPS); }
        if (u.pm < 64) {
            if (fr >= 14) {
#pragma unroll
                for (int ai = 0; ai < 2; ++ai)
#pragma unroll
                    for (int n = 0; n < 2; ++n) *(PG8_LAS f32x4*)(xch + (((wr * 4 + wc) * 8 + (fr - 14) * 4 + fq) * 16 + ai * 8 + n * 4)) = acc[ai][0][3][n] * rs[ai][3];
            }
            asm volatile("s_waitcnt lgkmcnt(0)" ::: "memory"); __builtin_amdgcn_s_barrier(); asm volatile("" ::: "memory");
#pragma unroll
            for (int n = 0; n < 2; ++n) {
                const f32x4 w0 = *(const f32x4*)(cw + colt + 4 * n), w1 = *(const f32x4*)(cw + 2816 + colt + 4 * n), w2 = *(const f32x4*)(cw + 5632 + colt + 4 * n), bb = *(const f32x4*)(cb + colt + 4 * n);
#pragma unroll
                for (int ai = 0; ai < 2; ++ai) {
                    f32x4 prevA = {0.f, 0.f, 0.f, 0.f};
                    const bool has_prev = (wr == 1) || (ai == 1);
                    #ifndef DIAG_T3
                    if (has_prev && fr >= 14) { const int pw = (wr == 1 ? 0 : 4) + wc, pai = (wr == 1) ? ai : 0; prevA = *(const PG8_LAS f32x4*)(xch + ((pw * 8 + (fr - 14) * 4 + fq) * 16 + pai * 8 + n * 4)); }
#endif
#pragma unroll
                    for (int m = 0; m < 4; ++m) {
                        const int row = row0 + ai * HALF + m * 16;
                        const f32x4 a = acc[ai][0][m][n] * rs[ai][m], uu = acc[ai][1][m][n] * rs[ai][m]; f32x4 gg;
#pragma unroll
                        for (int j = 0; j < 4; ++j) {
                            const float up1 = __shfl_up(a[j], 1, 16), up2 = __shfl_up(a[j], 2, 16), t15 = __shfl(prevA[j], 15, 16), t14 = __shfl(prevA[j], 14, 16);
                            const float p1 = fr == 0 ? t15 : up1, p2 = fr == 0 ? t14 : (fr == 1 ? t15 : up2);
                            const float c = bb[j] + w0[j] * p2 + w1[j] * p1 + w2[j] * a[j];
                            gg[j] = c * sigm(c) * uu[j];
                        }
                        *(u32x2*)(G + (size_t)row * 2816 + colt + 4 * n) = (u32x2){cvt_pk_bf16(gg[0], gg[1]), cvt_pk_bf16(gg[2], gg[3])};
                        if (ai == 0 && m == 0 && wr == 0 && fr < 2) { *(f32x4*)(HALO_A + (size_t)(u.pm * 2 + fr) * 2816 + colt + 4 * n) = a; *(f32x4*)(HALO_U + (size_t)(u.pm * 2 + fr) * 2816 + colt + 4 * n) = uu; }
                        if (ai == 1 && m == 3 && wr == 1 && fr >= 14) { *(f32x4*)(LASTA + (size_t)(u.pm * 2 + fr - 14) * 2816 + colt + 4 * n) = a;
                            if ((u.pm & 31) == 31) *(f32x4*)(ocp + (size_t)((u.pm >> 5) * 2 + fr - 14) * 2816 + colt + 4 * n) = a; }
                        prevA = a;
                    }
                }
            }
        } else {
#pragma unroll
            for (int n = 0; n < 2; ++n) {
                const f32x4 w0 = *(const f32x4*)(cw + colt + 4 * n), w1 = *(const f32x4*)(cw + 2816 + colt + 4 * n), w2 = *(const f32x4*)(cw + 5632 + colt + 4 * n), bb = *(const f32x4*)(cb + colt + 4 * n);
#pragma unroll
                for (int ai = 0; ai < 2; ++ai)
#pragma unroll
                    for (int m = 0; m < 4; ++m) {
                        const int row = row0 + ai * HALF + m * 16, rl = row - MPR, bs = rl >> 2, t = rl & 3;
                        const f32x4 a = acc[ai][0][m][n] * rs[ai][m], uu = acc[ai][1][m][n] * rs[ai][m]; f32x4 gg, s0 = {0.f, 0.f, 0.f, 0.f}, s1 = {0.f, 0.f, 0.f, 0.f};
                        const float* sc = sconv + (size_t)bs * 2 * 2816 + colt + 4 * n;
                        if (t == 0) s0 = *(const f32x4*)sc;
                        if (t <= 1) s1 = *(const f32x4*)(sc + 2816);
#pragma unroll
                        for (int j = 0; j < 4; ++j) {
                            const float up1 = __shfl_up(a[j], 1, 16), up2 = __shfl_up(a[j], 2, 16);
                            const float p1 = t == 0 ? s1[j] : up1, p2 = t == 0 ? s0[j] : (t == 1 ? s1[j] : up2);
                            const float c = bb[j] + w0[j] * p2 + w1[j] * p1 + w2[j] * a[j];
                            gg[j] = c * sigm(c) * uu[j];
                        }
                        *(u32x2*)(G + (size_t)row * 2816 + colt + 4 * n) = (u32x2){cvt_pk_bf16(gg[0], gg[1]), cvt_pk_bf16(gg[2], gg[3])};
                        if (t >= 2) *(f32x4*)(ocs + (size_t)(bs * 2 + t - 2) * 2816 + colt + 4 * n) = a;
                    }
            }
        }
    }
};
template <class Epi, class Sched, bool ALIGN_EPI = false, bool SP2 = false>
__device__ __forceinline__ void gemm_phase(PG8_LAS unsigned char* lds, const Gemm g, const Sched& S, const Epi& E) {
    int tid_ = threadIdx.x; asm volatile("" : "+v"(tid_));
    const int tid = tid_, wid = __builtin_amdgcn_readfirstlane(tid >> 6), lane = tid & 63, wr = wid >> 2, wc = wid & 3, fr = lane & 15, fq = lane >> 4;
    const int K = g.ldk, nt_def = g.K / BK;
    unsigned voffA[2], voffB[2];
#pragma unroll
    for (int i = 0; i < 2; ++i) { int R, C; stage_rc(tid * 16 + i * 8192, R, C); const int Rb = Epi::PERM ? ((R & ~31) + perm32(R & 31)) : R;
        voffA[i] = (unsigned)(R * K + C) * 2u; voffB[i] = (unsigned)(Rb * K + C) * 2u; }
    const size_t kstep = (size_t)(BK * 2);
    const size_t hstep = (size_t)HALF * K * 2;
    const size_t tstep = 2 * hstep;
    const unsigned ldsw = (unsigned)wid * 1024u;
    const int aoff = lds_byte(wr * 64 + fr, fq * 8), boff = lds_byte(wc * 32 + fr, fq * 8);
#define PG8_SA(b, h) (((b) * 2 + (h)) * HTB)
#define PG8_SB(b, h) ((4 + (b) * 2 + (h)) * HTB)
#define PG8_STAGE(bufoff, gbase, voff) do { _Pragma("unroll") for (int _i = 0; _i < 2; ++_i) \
        __builtin_amdgcn_global_load_lds((const unsigned*)((const char*)(gbase) + (voff)[_i]), (PG8_LAS unsigned*)(lds + (bufoff) + ldsw + _i * 8192), 16, 0, 0); } while (0)
#define PG8_LDA(dst, b, h) do { _Pragma("unroll") for (int m = 0; m < 4; ++m) _Pragma("unroll") for (int k = 0; k < 2; ++k) dst[m][k] = *(const PG8_LAS bf16x8*)(lds + PG8_SA(b, h) + aoff + m * 2048 + k * 1024); } while (0)
#define PG8_LDB(dst, b, h) do { _Pragma("unroll") for (int n = 0; n < 2; ++n) _Pragma("unroll") for (int k = 0; k < 2; ++k) dst[n][k] = *(const PG8_LAS bf16x8*)(lds + PG8_SB(b, h) + boff + n * 2048 + k * 1024); } while (0)
#define PG8_MMA(ai, bj, At, Bt) do { __builtin_amdgcn_s_setprio(1); _Pragma("unroll") for (int m = 0; m < 4; ++m) _Pragma("unroll") for (int n = 0; n < 2; ++n) _Pragma("unroll") for (int k = 0; k < 2; ++k) \
        acc[ai][bj][m][n] = __builtin_amdgcn_mfma_f32_16x16x32_bf16(Bt[n][k], At[m][k], acc[ai][bj][m][n], 0, 0, 0); __builtin_amdgcn_s_setprio(0); } while (0)
#define PG8_WAIT_V(n) asm volatile("s_waitcnt vmcnt(" #n ")" ::: "memory")
#define PG8_WAIT_L(n) asm volatile("s_waitcnt lgkmcnt(" #n ")" ::: "memory")
#define PG8_BAR __builtin_amdgcn_s_barrier()
#define PG8_SCHED __builtin_amdgcn_sched_barrier(0)
    Unit cur, nxt; int ui = 0;
    if (!S.next(0, cur)) return;
    f32x4 acc[2][2][4][2];
#pragma unroll
    for (int a = 0; a < 2; ++a)
#pragma unroll
        for (int b = 0; b < 2; ++b)
#pragma unroll
            for (int m = 0; m < 4; ++m)
#pragma unroll
                for (int n = 0; n < 2; ++n) acc[a][b][m][n] = (f32x4){0.f, 0.f, 0.f, 0.f};
    bf16x8 At[4][2], B0[2][2], B1[2][2];
    const char* cA = (const char*)g.A + (size_t)cur.pm * tstep + cur.kb; const char* cB = (const char*)g.Bt + (size_t)cur.pn * tstep + cur.kb;
    S.a_ready(cur);
    if constexpr (SP2) {
        PG8_STAGE(PG8_SB(0, 0), cB, voffB); PG8_STAGE(PG8_SB(0, 1), cB + hstep, voffB); PG8_STAGE(PG8_SA(0, 0), cA, voffA); PG8_STAGE(PG8_SA(0, 1), cA + hstep, voffA);
        if (wr == 1) PG8_BAR;
        PG8_WAIT_V(2); PG8_BAR;
        PG8_STAGE(PG8_SB(1, 0), cB + kstep, voffB); PG8_STAGE(PG8_SA(1, 0), cA + kstep, voffA); PG8_STAGE(PG8_SB(1, 1), cB + hstep + kstep, voffB);
        PG8_WAIT_V(6); PG8_BAR;
    } else {
        PG8_STAGE(PG8_SB(0, 0), cB, voffB); PG8_STAGE(PG8_SA(0, 0), cA, voffA); PG8_STAGE(PG8_SB(0, 1), cB + hstep, voffB); PG8_STAGE(PG8_SA(0, 1), cA + hstep, voffA);
        if (wr == 1) PG8_BAR;
        PG8_WAIT_V(4); PG8_BAR;
        PG8_STAGE(PG8_SB(1, 0), cB + kstep, voffB); PG8_STAGE(PG8_SA(1, 0), cA + kstep, voffA); PG8_STAGE(PG8_SB(1, 1), cB + hstep + kstep, voffB);
        PG8_WAIT_V(6); PG8_BAR;
    }
    for (;;) {
        const bool has_next = S.next(ui + 1, nxt);
        const char* nA = has_next ? (const char*)g.A + (size_t)nxt.pm * tstep + nxt.kb : cA; const char* nB = has_next ? (const char*)g.Bt + (size_t)nxt.pn * tstep + nxt.kb : cB;
        const int nt = cur.nt ? cur.nt : nt_def;
        for (int t = 0; t < nt; t += 2) {
            const bool last = (t == nt - 2);
            const char* a1 = cA + (size_t)(t + 1) * kstep;
            const char* a2 = last ? nA : cA + (size_t)(t + 2) * kstep; const char* b2 = last ? nB : cB + (size_t)(t + 2) * kstep;
            const char* a3 = a2 + kstep; const char* b3 = b2 + kstep;
            if (last && has_next) S.a_ready(nxt);
            if constexpr (SP2) {
            PG8_LDB(B0, 0, 0); PG8_LDB(B1, 0, 1); PG8_SCHED; PG8_LDA(At, 0, 0); PG8_STAGE(PG8_SA(1, 1), a1 + hstep, voffA);
            PG8_WAIT_V(8); PG8_WAIT_L(0); PG8_BAR; PG8_MMA(0, 0, At, B0); PG8_MMA(0, 1, At, B1); PG8_BAR; PG8_SCHED;
            PG8_LDA(At, 0, 1); PG8_STAGE(PG8_SB(0, 0), b2, voffB); PG8_STAGE(PG8_SB(0, 1), b2 + hstep, voffB); PG8_STAGE(PG8_SA(0, 0), a2, voffA);
            PG8_WAIT_V(8); PG8_WAIT_L(0); PG8_BAR; PG8_MMA(1, 0, At, B0); PG8_MMA(1, 1, At, B1); PG8_BAR; PG8_SCHED;
            PG8_LDB(B0, 1, 0); PG8_LDB(B1, 1, 1); PG8_SCHED; PG8_LDA(At, 1, 0); PG8_STAGE(PG8_SA(0, 1), a2 + hstep, voffA);
            PG8_WAIT_V(8); PG8_WAIT_L(0); PG8_BAR; PG8_MMA(0, 0, At, B0); PG8_MMA(0, 1, At, B1); PG8_BAR; PG8_SCHED;
            PG8_LDA(At, 1, 1); PG8_STAGE(PG8_SB(1, 0), b3, voffB); PG8_STAGE(PG8_SB(1, 1), b3 + hstep, voffB); PG8_STAGE(PG8_SA(1, 0), a3, voffA);
            PG8_WAIT_V(8); PG8_WAIT_L(0); PG8_BAR; PG8_MMA(1, 0, At, B0); PG8_MMA(1, 1, At, B1); PG8_BAR; PG8_SCHED;
            } else {
            PG8_LDB(B0, 0, 0); PG8_SCHED; PG8_LDA(At, 0, 0); PG8_STAGE(PG8_SA(1, 1), a1 + hstep, voffA);
            PG8_WAIT_L(8); PG8_BAR; PG8_WAIT_L(0); PG8_MMA(0, 0, At, B0); PG8_BAR; PG8_SCHED;
            PG8_LDB(B1, 0, 1); PG8_STAGE(PG8_SB(0, 0), b2, voffB);
            PG8_BAR; PG8_WAIT_L(0); PG8_MMA(0, 1, At, B1); PG8_BAR;
            PG8_LDA(At, 0, 1); PG8_STAGE(PG8_SA(0, 0), a2, voffA);
            PG8_BAR; PG8_WAIT_L(0); PG8_MMA(1, 0, At, B0); PG8_BAR; PG8_SCHED;
            PG8_STAGE(PG8_SB(0, 1), b2 + hstep, voffB);
            PG8_WAIT_V(6); PG8_BAR; PG8_MMA(1, 1, At, B1); PG8_BAR;
            PG8_LDB(B0, 1, 0); PG8_SCHED; PG8_LDA(At, 1, 0); PG8_STAGE(PG8_SA(0, 1), a2 + hstep, voffA);
            PG8_WAIT_L(8); PG8_BAR; PG8_WAIT_L(0); PG8_MMA(0, 0, At, B0); PG8_BAR; PG8_SCHED;
            PG8_LDB(B1, 1, 1); PG8_STAGE(PG8_SB(1, 0), b3, voffB);
            PG8_BAR; PG8_WAIT_L(0); PG8_MMA(0, 1, At, B1); PG8_BAR;
            PG8_LDA(At, 1, 1); PG8_STAGE(PG8_SA(1, 0), a3, voffA);
            PG8_BAR; PG8_WAIT_L(0); PG8_MMA(1, 0, At, B0); PG8_BAR; PG8_SCHED;
            PG8_STAGE(PG8_SB(1, 1), b3 + hstep, voffB);
            PG8_WAIT_V(6); PG8_BAR; PG8_MMA(1, 1, At, B1); PG8_BAR;
            }
        }
        if constexpr (ALIGN_EPI) { if (wr == 0) PG8_BAR; }
        if constexpr (!Epi::AFTER_DRAIN) { int l_; asm volatile("v_mbcnt_lo_u32_b32 %0, -1, 0\n\tv_mbcnt_hi_u32_b32 %0, -1, %0" : "=v"(l_)); E(acc, cur, wr, wc, l_ & 15, l_ >> 4); S.done(cur); }
        if (!has_next) break;
#pragma unroll
        for (int a = 0; a < 2; ++a)
#pragma unroll
            for (int b = 0; b < 2; ++b)
#pragma unroll
                for (int m = 0; m < 4; ++m)
#pragma unroll
                    for (int n = 0; n < 2; ++n) acc[a][b][m][n] = (f32x4){0.f, 0.f, 0.f, 0.f};
        cur = nxt; cA = nA; cB = nB; ++ui;
        if constexpr (ALIGN_EPI) { if (wr == 1) PG8_BAR; }
    }
    PG8_WAIT_V(0);
    if constexpr (!ALIGN_EPI) { if (wr == 0) PG8_BAR; }
    PG8_BAR;
    if constexpr (Epi::AFTER_DRAIN) { E.fused(acc, cur, wr, wc, fr, fq, lds, wid, lane); S.done(cur); }
#undef PG8_SA
#undef PG8_SB
#undef PG8_STAGE
#undef PG8_LDA
#undef PG8_LDB
#undef PG8_MMA
#undef PG8_WAIT_V
#undef PG8_WAIT_L
#undef PG8_BAR
#undef PG8_SCHED
}
}

#ifndef PG8_SP2
#define PG8_SP2 true
#endif
#ifndef PG8_ALIGN
#define PG8_ALIGN true
#endif
constexpr int NWAVES = 8;
constexpr int DM = 1024, TP = 8192, NBP = 2, MP = NBP * TP, NBS = 128, TS = 4, MS = NBS * TS, MALL = MP + MS;
constexpr int NIN = 3584, DFF = 2816, NPAGES = 16, PAGE = 128, PAST = 2048;
constexpr float EPSF = 1e-6f, LOG2E_F = 1.4426950408889634f;
constexpr size_t O_YP = 0, O_YS = 16777216, O_KP = 17301504, O_VP = 25690112, O_HP = 34078720, O_CP = 34209792, O_KS = 34221056, O_VS = 34483200, O_HS = 34745344, O_CS = 43133952, O_END = 43854848;
constexpr size_t MiB = 1u << 20;
constexpr size_t WS_CTL = 0, CTL_ZERO_BYTES = 1 * MiB;
constexpr size_t WS_WIN = 2 * MiB;
constexpr size_t WS_WOUT = 10 * MiB;
constexpr size_t WS_WGU = 12 * MiB;
constexpr size_t WS_WDN = 24 * MiB;
constexpr size_t WS_RSTD1 = 30 * MiB;
constexpr size_t WS_SSQP = 31 * MiB;
constexpr size_t WS_HALOA = 33 * MiB, WS_HALOU = 35 * MiB, WS_LASTA = 37 * MiB;
constexpr size_t WS_DTOT = 39 * MiB;
constexpr size_t WS_XB = 40 * MiB;
constexpr size_t WS_QB = 74 * MiB, WS_KB = 91 * MiB, WS_VB = 108 * MiB, WS_HQ = 125 * MiB, WS_HV = 142 * MiB, WS_HG = 159 * MiB;
constexpr size_t WS_HLF = 176 * MiB;
constexpr size_t WS_MIX = 210 * MiB;
constexpr size_t WS_X1B = 244 * MiB;
constexpr size_t WS_UBUF = 278 * MiB;
constexpr size_t WS_SST = 295 * MiB;
constexpr size_t WS_G = 312 * MiB;
constexpr size_t WS_PART = 404 * MiB;
constexpr size_t WS_DPART = 428 * MiB;
constexpr size_t WS_END = 438 * MiB;
constexpr int CW_TMO = 0, CW_BAR = 4096, CW_QDEC = 8192, CW_QATT = 8256, CW_DCNT = 8448;
constexpr int RING_OFF = 0, RING_BYTES = 131072;
constexpr int LDSCTL_OFF = RING_BYTES, MISC_OFF = LDSCTL_OFF + 320;
constexpr int BL_OFF = RING_BYTES + 512;
constexpr int SCAL_OFF = BL_OFF + 2048;
constexpr int XCH_OFF = SCAL_OFF + 128;
constexpr int ALS_OFF = XCH_OFF + 4096;
constexpr int LDS_BYTES = 147456;
static_assert(ALS_OFF + 1024 <= LDS_BYTES, "LDS map");

#define GAS __attribute__((address_space(1)))
#define LAS __attribute__((address_space(3)))
typedef unsigned short bf16;
typedef unsigned v4u __attribute__((ext_vector_type(4)));
typedef unsigned v2u __attribute__((ext_vector_type(2)));
typedef float f32x4 __attribute__((ext_vector_type(4)));
typedef float f32x16 __attribute__((ext_vector_type(16)));
typedef short bf16x8 __attribute__((ext_vector_type(8)));
typedef short s16x4 __attribute__((ext_vector_type(4)));
typedef GAS unsigned gu32;
#define RLX_AGENT __ATOMIC_RELAXED, __HIP_MEMORY_SCOPE_AGENT
#define LDS_WAIT() asm volatile("s_waitcnt lgkmcnt(0)" ::: "memory")
#define VM_WAIT() asm volatile("s_waitcnt vmcnt(0)" ::: "memory")
#define WG_SYNC() do { asm volatile("s_waitcnt vmcnt(0) lgkmcnt(0)" ::: "memory"); __builtin_amdgcn_s_barrier(); asm volatile("" ::: "memory"); } while (0)
#define LDS_SYNC() do { asm volatile("s_waitcnt lgkmcnt(0)" ::: "memory"); __builtin_amdgcn_s_barrier(); asm volatile("" ::: "memory"); } while (0)
__device__ __forceinline__ unsigned f2bf(float f) { unsigned u = __builtin_bit_cast(unsigned, f); return (u + 0x7fffu + ((u >> 16) & 1u)) >> 16; }
__device__ __forceinline__ unsigned pk2(float lo, float hi) { return pg8::cvt_pk_bf16(lo, hi); }
__device__ __forceinline__ float bf2f(unsigned short h) { return __builtin_bit_cast(float, (unsigned)h << 16); }
__device__ __forceinline__ float sigm_f(float x) { return __builtin_amdgcn_rcpf(1.0f + __builtin_amdgcn_exp2f(-x * LOG2E_F)); }
__device__ __forceinline__ float ex2(float x) { return __builtin_amdgcn_exp2f(x); }
__device__ __forceinline__ int crow(int r, int hi) { return (r & 3) + 8 * (r >> 2) + 4 * hi; }
#define XB_TMO      128
#define XB_XCNT(j)  (256  + 64 * (j))
#define XB_XSUB(j)  (1280 + 64 * (j))
#define XB_XGEN(j)  (2304 + 64 * (j))
#define XB_TOP      3328
#define XB_TOPGEN   3392
#define XCD_BAR_WORDS 3456
#define XB_SPIN_CAP (1u << 18)

__device__ __forceinline__ unsigned xb_ld(unsigned* p)              { return __hip_atomic_load(p, __ATOMIC_RELAXED, __HIP_MEMORY_SCOPE_AGENT); }
__device__ __forceinline__ unsigned xb_add(unsigned* p, unsigned v) { return __hip_atomic_fetch_add(p, v, __ATOMIC_RELAXED, __HIP_MEMORY_SCOPE_AGENT); }
__device__ __forceinline__ unsigned xb_xcc_id() { return (unsigned)__builtin_amdgcn_s_getreg((3 << 11) | 20) & 0xFu; }
#define XB_SPIN(cond, bar) do { unsigned _sp = 0; while (cond) { __builtin_amdgcn_s_sleep(1); \
    if ((++_sp & 255u) == 0u) { if (xb_ld(&(bar)[XB_TMO])) break; if (_sp > XB_SPIN_CAP) { atomicAdd(&(bar)[XB_TMO], 1u); break; } } } } while (0)

struct XcdBarrier {
    unsigned* bar; unsigned x;
    volatile LAS unsigned* st;
};

__device__ __forceinline__ XcdBarrier xcd_barrier_post(unsigned* bar, volatile LAS unsigned* st) {
    XcdBarrier b; b.bar = bar; b.x = xb_xcc_id(); b.st = st;
    if (threadIdx.x == 0) (void)xb_add(&bar[XB_XCNT(b.x)], 1u);
    return b;
}
__device__ __forceinline__ void xcd_barrier_complete(unsigned* bar, unsigned x, unsigned& nloc, unsigned& nx) {
    const unsigned G = gridDim.x * gridDim.y * gridDim.z;
    unsigned sum, cnt, mine, sp = 0u;
    for (;;) {
        sum = 0u; cnt = 0u; mine = 0u;
#pragma unroll
        for (unsigned j = 0; j < 16; ++j) { const unsigned c = xb_ld(&bar[XB_XCNT(j)]); sum += c; cnt += (c > 0u) ? 1u : 0u; mine = (j == x) ? c : mine; }
        if (sum == G) break;
        __builtin_amdgcn_s_sleep(1);
        if ((++sp & 255u) == 0u) { if (xb_ld(&bar[XB_TMO])) break; if (sp > XB_SPIN_CAP) { atomicAdd(&bar[XB_TMO], 1u); break; } }
    }
    nloc = mine > 0u ? mine : 1u; nx = cnt > 0u ? cnt : 1u;
}

__device__ __forceinline__ void xcd_barrier(const XcdBarrier& b) {
    asm volatile("s_waitcnt vmcnt(0)" ::: "memory");
    __syncthreads();
    if (threadIdx.x == 0) {
        unsigned* bar = b.bar;
        __builtin_amdgcn_s_waitcnt(0);
        unsigned nloc = b.st[0], nx = b.st[1];
        if (nloc == 0u) { xcd_barrier_complete(bar, b.x, nloc, nx); b.st[0] = nloc; b.st[1] = nx; }
        const unsigned old = xb_add(&bar[XB_XSUB(b.x)], 1u);
        const unsigned gen = old / nloc;
        if (old + 1u == (gen + 1u) * nloc) {
            __builtin_amdgcn_fence(__ATOMIC_RELEASE, "agent");
            asm volatile("s_waitcnt vmcnt(0)" ::: "memory");
            const unsigned og = xb_add(&bar[XB_TOP], 1u);
            const unsigned tg = og / nx;
            if (og + 1u == (tg + 1u) * nx) xb_add(&bar[XB_TOPGEN], 1u);
            else XB_SPIN(xb_ld(&bar[XB_TOPGEN]) == tg, bar);
            __builtin_amdgcn_fence(__ATOMIC_ACQUIRE, "agent");
            xb_add(&bar[XB_XGEN(b.x)], 1u);
            asm volatile("s_waitcnt vmcnt(0)" ::: "memory");
        } else {
            XB_SPIN(xb_ld(&bar[XB_XGEN(b.x)]) == gen, bar);
            __builtin_amdgcn_fence(__ATOMIC_ACQUIRE, "agent");
            asm volatile("s_waitcnt vmcnt(0)" ::: "memory");
        }
    }
    __syncthreads();
}

__device__ __forceinline__ float wave_sum(float v) {
#pragma unroll
    for (int o = 1; o < 64; o <<= 1) v += __shfl_xor(v, o);
    return v;
}
template <class KS>
__device__ __forceinline__ void p0_transpose_item(const float* W, int K, int N, bf16* WT, int kb, int nb, int prow, LAS float* scr, int lane, const KS& ks) {
    const int k0 = 64 * kb, n0 = 32 * nb;
#pragma unroll 8
    for (int i = 0; i < 32; ++i) { const int kk = 2 * i + (lane >> 5); scr[kk * 33 + (lane & 31)] = W[(size_t)(k0 + kk) * N + n0 + (lane & 31)] * ks(k0 + kk); }
    LDS_WAIT(); asm volatile("" ::: "memory");
    const int c = lane & 7;
#pragma unroll
    for (int j = 0; j < 4; ++j) { const int n = (lane >> 3) + 8 * j; const LAS float* s = scr + (8 * c) * 33 + n;
        v4u o; o.x = pk2(s[0 * 33], s[1 * 33]); o.y = pk2(s[2 * 33], s[3 * 33]); o.z = pk2(s[4 * 33], s[5 * 33]); o.w = pk2(s[6 * 33], s[7 * 33]);
        *(GAS v4u*)(WT + (size_t)(prow + n) * K + k0 + 8 * c) = o; }
    LDS_WAIT(); asm volatile("" ::: "memory");
}
struct PIn {
    const float *xp, *xs, *ck, *cv; const int* pt; const float *sh, *sconv, *relb, *g1, *win, *gqk, *lqk, *subg, *hlb, *ong, *wout, *g2, *wg, *wu, *cw, *cb, *wd;
};
constexpr int H_QT = 0, H_KI = 17408, H_KET = 34816, H_VT = 53248, H_ST = 71680, H_P = 106496, H_DEC = 115712, H_TOT = 116224, H_END = 118272;
static_assert(H_END <= RING_BYTES, "hgrn LDS");
#define MFMA32(a, b, c) __builtin_amdgcn_mfma_f32_32x32x16_bf16((a), (b), (c), 0, 0, 0)
template <bool OUT>
__device__ __forceinline__ void hgrn_unit(int unit, LAS unsigned char* lds, const float* HLF, const bf16* HQ, const bf16* HV, const bf16* HG, bf16* MIX, float* UBUF, float* DTOT, const float* SST) {
    const int tid = threadIdx.x, lane = tid & 63, wid = __builtin_amdgcn_readfirstlane(tid >> 6), r32 = lane & 31, hi = lane >> 5;
    const int bh = unit >> 5, sc = unit & 31, b = bh >> 2, h = bh & 3, col0 = h * 128;
    const int row_base = b * TP + sc * 256, kx = tid & 127, tq = tid >> 7;
    const int ki = wid & 3, vi0 = 2 * (wid >> 2);
    LAS bf16* QT = (LAS bf16*)(lds + H_QT); LAS bf16* KI = (LAS bf16*)(lds + H_KI); LAS bf16* KET = (LAS bf16*)(lds + H_KET); LAS bf16* VT = (LAS bf16*)(lds + H_VT);
    LAS bf16* ST = (LAS bf16*)(lds + H_ST); LAS bf16* PP = (LAS bf16*)(lds + H_P); LAS float* DEC = (LAS float*)(lds + H_DEC); LAS float* TOT = (LAS float*)(lds + H_TOT);
    LAS float* OS = (LAS float*)(lds + H_QT);
    f32x16 S[2];
#pragma unroll
    for (int j = 0; j < 2; ++j)
#pragma unroll
        for (int r = 0; r < 16; ++r) S[j][r] = OUT ? SST[(size_t)unit * 16384 + (32 * ki + crow(r, hi)) * 128 + 32 * (vi0 + j) + r32] : 0.f;
    float dacc = 0.f;
    for (int c = 0; c < 4; ++c) {
        const int rows = row_base + 64 * c + 16 * tq;
        float cs[16]; unsigned short vv[16], qq[16];
#pragma unroll
        for (int i = 0; i < 16; ++i) { cs[i] = HLF[(size_t)(rows + i) * 512 + col0 + kx]; vv[i] = HV[(size_t)(rows + i) * 512 + col0 + kx]; if (OUT) qq[i] = HQ[(size_t)(rows + i) * 512 + col0 + kx]; }
        float lf[16];
#pragma unroll
        for (int i = 0; i < 16; ++i) { lf[i] = cs[i]; if (i) cs[i] += cs[i - 1]; }
        TOT[tq * 128 + kx] = cs[15];
        LDS_SYNC();
        float off = 0.f, blast = 0.f;
#pragma unroll
        for (int q = 0; q < 4; ++q) { const float t = TOT[q * 128 + kx]; if (q < tq) off += t; blast += t; }
        unsigned kew[8], vtw[8];
#pragma unroll
        for (int i = 0; i < 16; i += 2) {
            float ke[2];
#pragma unroll
            for (int e = 0; e < 2; ++e) { const float bi = off + cs[i + e], kk = 1.0f - ex2(lf[i + e] * LOG2E_F); ke[e] = kk * ex2((blast - bi) * LOG2E_F);
                if (OUT) { QT[(16 * tq + i + e) * 136 + kx] = (bf16)f2bf(bf2f(qq[i + e]) * ex2(bi * LOG2E_F)); KI[(16 * tq + i + e) * 136 + kx] = (bf16)f2bf(kk * ex2(-bi * LOG2E_F)); } }
            kew[i >> 1] = pk2(ke[0], ke[1]); vtw[i >> 1] = (unsigned)vv[i] | ((unsigned)vv[i + 1] << 16);
        }
        *(LAS v4u*)(KET + kx * 72 + 16 * tq) = (v4u){kew[0], kew[1], kew[2], kew[3]}; *(LAS v4u*)(KET + kx * 72 + 16 * tq + 8) = (v4u){kew[4], kew[5], kew[6], kew[7]};
        *(LAS v4u*)(VT + kx * 72 + 16 * tq) = (v4u){vtw[0], vtw[1], vtw[2], vtw[3]}; *(LAS v4u*)(VT + kx * 72 + 16 * tq + 8) = (v4u){vtw[4], vtw[5], vtw[6], vtw[7]};
        if (tq == 0) { DEC[kx] = ex2(blast * LOG2E_F); dacc += blast; }
        if (OUT && c == 0) {
#pragma unroll
            for (int j = 0; j < 2; ++j)
#pragma unroll
                for (int g = 0; g < 4; ++g) *(LAS v2u*)(ST + (32 * (vi0 + j) + r32) * 136 + 32 * ki + 8 * g + 4 * hi) = (v2u){pk2(S[j][4 * g], S[j][4 * g + 1]), pk2(S[j][4 * g + 2], S[j][4 * g + 3])};
        }
        LDS_SYNC();
        f32x16 oacc;
        if (OUT) {
            if (wid < 3) {
                const int ti = wid > 0, si = wid == 2; f32x16 am;
#pragma unroll
                for (int r = 0; r < 16; ++r) am[r] = 0.f;
#pragma unroll
                for (int ks = 0; ks < 8; ++ks) { const bf16x8 a = *(const LAS bf16x8*)(QT + (32 * ti + r32) * 136 + 16 * ks + 8 * hi), bb = *(const LAS bf16x8*)(KI + (32 * si + r32) * 136 + 16 * ks + 8 * hi); am = MFMA32(a, bb, am); }
#pragma unroll
                for (int r = 0; r < 16; ++r) { const int t = 32 * ti + crow(r, hi), s = 32 * si + r32; PP[t * 72 + s] = (bf16)f2bf(s <= t ? am[r] : 0.f); }
            } else if (wid == 3) {
#pragma unroll
                for (int r = 0; r < 16; ++r) PP[crow(r, hi) * 72 + 32 + r32] = 0;
            }
            LDS_SYNC();
            const int ti = wid & 1, vi = wid >> 1;
#pragma unroll
            for (int r = 0; r < 16; ++r) oacc[r] = 0.f;
#pragma unroll
            for (int ks = 0; ks < 4; ++ks) { const bf16x8 a = *(const LAS bf16x8*)(PP + (32 * ti + r32) * 72 + 16 * ks + 8 * hi), bb = *(const LAS bf16x8*)(VT + (32 * vi + r32) * 72 + 16 * ks + 8 * hi); oacc = MFMA32(a, bb, oacc); }
#pragma unroll
            for (int ks = 0; ks < 8; ++ks) { const bf16x8 a = *(const LAS bf16x8*)(QT + (32 * ti + r32) * 136 + 16 * ks + 8 * hi), bb = *(const LAS bf16x8*)(ST + (32 * vi + r32) * 136 + 16 * ks + 8 * hi); oacc = MFMA32(a, bb, oacc); }
        }
        {
            float dk[16];
#pragma unroll
            for (int r = 0; r < 16; ++r) dk[r] = DEC[32 * ki + crow(r, hi)];
#pragma unroll
            for (int j = 0; j < 2; ++j)
#pragma unroll
                for (int r = 0; r < 16; ++r) S[j][r] *= dk[r];
#pragma unroll
            for (int ks = 0; ks < 4; ++ks) { const bf16x8 a = *(const LAS bf16x8*)(KET + (32 * ki + r32) * 72 + 16 * ks + 8 * hi);
#pragma unroll
                for (int j = 0; j < 2; ++j) { const bf16x8 bb = *(const LAS bf16x8*)(VT + (32 * (vi0 + j) + r32) * 72 + 16 * ks + 8 * hi); S[j] = MFMA32(a, bb, S[j]); } }
        }
        if (OUT) {
            LDS_SYNC();
            const int ti = wid & 1, vi = wid >> 1;
#pragma unroll
            for (int r = 0; r < 16; ++r) OS[(32 * ti + crow(r, hi)) * 132 + 32 * vi + r32] = oacc[r];
#pragma unroll
            for (int j = 0; j < 2; ++j)
#pragma unroll
                for (int g = 0; g < 4; ++g) *(LAS v2u*)(ST + (32 * (vi0 + j) + r32) * 136 + 32 * ki + 8 * g + 4 * hi) = (v2u){pk2(S[j][4 * g], S[j][4 * g + 1]), pk2(S[j][4 * g + 2], S[j][4 * g + 3])};
            LDS_SYNC();
            const int t = tid >> 3, seg = tid & 7; const int row = row_base + 64 * c + t;
            f32x4 o4[4]; float ss = 0.f;
#pragma unroll
            for (int i = 0; i < 4; ++i) { o4[i] = *(const LAS f32x4*)(OS + t * 132 + 16 * seg + 4 * i); ss += (o4[i][0] * o4[i][0] + o4[i][1] * o4[i][1]) + (o4[i][2] * o4[i][2] + o4[i][3] * o4[i][3]); }
            ss += __shfl_xor(ss, 1); ss += __shfl_xor(ss, 2); ss += __shfl_xor(ss, 4);
            const float rstd = rsqrtf(ss * (1.0f / 128.0f) + EPSF);
            const v4u g0 = *(const v4u*)(HG + (size_t)row * 512 + col0 + 16 * seg), g1 = *(const v4u*)(HG + (size_t)row * 512 + col0 + 16 * seg + 8);
            const unsigned gw[8] = {g0.x, g0.y, g0.z, g0.w, g1.x, g1.y, g1.z, g1.w}; unsigned ow[8];
#pragma unroll
            for (int i = 0; i < 8; ++i) { const float a = o4[i >> 1][2 * (i & 1)] * rstd * __builtin_bit_cast(float, gw[i] << 16), bq = o4[i >> 1][2 * (i & 1) + 1] * rstd * __builtin_bit_cast(float, gw[i] & 0xffff0000u); ow[i] = pk2(a, bq); }
            *(v4u*)(MIX + (size_t)row * 1024 + 512 + col0 + 16 * seg) = (v4u){ow[0], ow[1], ow[2], ow[3]}; *(v4u*)(MIX + (size_t)row * 1024 + 512 + col0 + 16 * seg + 8) = (v4u){ow[4], ow[5], ow[6], ow[7]};
        }
        LDS_SYNC();
    }
    if (!OUT) {
#pragma unroll
        for (int j = 0; j < 2; ++j)
#pragma unroll
            for (int r = 0; r < 16; ++r) UBUF[(size_t)unit * 16384 + (32 * ki + crow(r, hi)) * 128 + 32 * (vi0 + j) + r32] = S[j][r];
        if (tq == 0) DTOT[unit * 128 + kx] = ex2(dacc * LOG2E_F);
    }
}
__device__ __forceinline__ void hgrn_scan(int gtid, int gsize, const float* UBUF, const float* DTOT, float* SST, float* ohp) {
    for (int e = gtid; e < 8 * 16384; e += gsize) {
        const int bh = e >> 14, idx = e & 16383, k = idx >> 7; float s = 0.f;
#pragma unroll 8
        for (int sc = 0; sc < 32; ++sc) { const int unit = bh * 32 + sc; SST[(size_t)unit * 16384 + idx] = s; s = DTOT[unit * 128 + k] * s + UBUF[(size_t)unit * 16384 + idx]; }
        ohp[(size_t)bh * 16384 + idx] = s;
    }
}
__device__ __forceinline__ void hgrn_sample_unit(int unit, LAS unsigned char* lds, const float* sh, const float* HLF, const bf16* HQ, const bf16* HV, const bf16* HG, bf16* MIX, float* ohs) {
    const int tid = threadIdx.x, wid = tid >> 6, b = unit >> 2, h = unit & 3, v4 = tid & 31, kq = tid >> 5;
    LAS float* OP = (LAS float*)lds;
    LAS float* PS = (LAS float*)(lds + 32768);
    const float* s0 = sh + ((size_t)unit * 128 + 8 * kq) * 128 + 4 * v4;
    f32x4 S[8];
#pragma unroll
    for (int i = 0; i < 8; ++i) S[i] = *(const f32x4*)(s0 + i * 128);
#pragma unroll
    for (int t = 0; t < 4; ++t) {
        const size_t rb = (size_t)(MP + 4 * b + t) * 512 + h * 128;
        const v2u vw = *(const v2u*)(HV + rb + 4 * v4);
        const f32x4 vv = {__builtin_bit_cast(float, vw.x << 16), __builtin_bit_cast(float, vw.x & 0xffff0000u), __builtin_bit_cast(float, vw.y << 16), __builtin_bit_cast(float, vw.y & 0xffff0000u)};
        f32x4 po = {0.f, 0.f, 0.f, 0.f};
#pragma unroll
        for (int i = 0; i < 8; ++i) { const float f = ex2(HLF[rb + 8 * kq + i] * LOG2E_F), q = bf2f(HQ[rb + 8 * kq + i]); S[i] = S[i] * f + vv * (1.0f - f); po += S[i] * q; }
        *(LAS f32x4*)(OP + (t * 16 + kq) * 128 + 4 * v4) = po;
    }
    float* so = ohs + ((size_t)unit * 128 + 8 * kq) * 128 + 4 * v4;
#pragma unroll
    for (int i = 0; i < 8; ++i) *(f32x4*)(so + i * 128) = S[i];
    LDS_SYNC();
    const int t = tid >> 7, v = tid & 127; float o = 0.f;
#pragma unroll
    for (int q = 0; q < 16; ++q) o += OP[(t * 16 + q) * 128 + v];
    const float ps = wave_sum(o * o);
    if ((tid & 63) == 0) PS[wid] = ps;
    LDS_SYNC();
    const float rstd = rsqrtf((PS[2 * t] + PS[2 * t + 1]) * (1.0f / 128.0f) + EPSF);
    const size_t row = (size_t)(MP + 4 * b + t);
    MIX[row * 1024 + 512 + h * 128 + v] = (bf16)f2bf(o * rstd * bf2f(HG[row * 512 + h * 128 + v]));
    LDS_SYNC();
}

#ifdef DIAG_T9
__device__ __forceinline__ void hgrn_seq_unit(int bh, LAS unsigned char* lds, const float* HLF, const bf16* HQ, const bf16* HV, const bf16* HG, bf16* MIX) {
    const int tid = threadIdx.x, wid = tid >> 6, b = bh >> 2, h = bh & 3, v4 = tid & 31, kq = tid >> 5;
    LAS float* OP = (LAS float*)lds; LAS float* PS = (LAS float*)(lds + 32768);
    f32x4 S[8];
#pragma unroll
    for (int i = 0; i < 8; ++i) S[i] = (f32x4){0.f, 0.f, 0.f, 0.f};
    for (int g = 0; g < TP / 4; ++g) {
#pragma unroll
        for (int t = 0; t < 4; ++t) {
            const size_t rb = (size_t)(b * TP + 4 * g + t) * 512 + h * 128;
            const v2u vw = *(const v2u*)(HV + rb + 4 * v4);
            const f32x4 vv = {__builtin_bit_cast(float, vw.x << 16), __builtin_bit_cast(float, vw.x & 0xffff0000u), __builtin_bit_cast(float, vw.y << 16), __builtin_bit_cast(float, vw.y & 0xffff0000u)};
            f32x4 po = {0.f, 0.f, 0.f, 0.f};
#pragma unroll
            for (int i = 0; i < 8; ++i) { const float f = ex2(HLF[rb + 8 * kq + i] * LOG2E_F), q = bf2f(HQ[rb + 8 * kq + i]); S[i] = S[i] * f + vv * (1.0f - f); po += S[i] * q; }
            *(LAS f32x4*)(OP + (t * 16 + kq) * 128 + 4 * v4) = po;
        }
        LDS_SYNC();
        const int t = tid >> 7, v = tid & 127; float o = 0.f;
#pragma unroll
        for (int q = 0; q < 16; ++q) o += OP[(t * 16 + q) * 128 + v];
        const float ps = wave_sum(o * o);
        if ((tid & 63) == 0) PS[wid] = ps;
        LDS_SYNC();
        const float rstd = rsqrtf((PS[2 * t] + PS[2 * t + 1]) * (1.0f / 128.0f) + EPSF);
        const size_t row = (size_t)(b * TP + 4 * g + t);
        if (DIAG_SEL(4 * g + t)) MIX[row * 1024 + 512 + h * 128 + v] = (bf16)f2bf(o * rstd * bf2f(HG[row * 512 + h * 128 + v]));
        LDS_SYNC();
    }
}
#endif
namespace att {
constexpr int SLOT = 16384, NSLOT = 3, L_K = 0, L_V = NSLOT * SLOT, L_STG = 0, STG_BYTES = 17408;
static_assert(L_V + NSLOT * SLOT <= RING_BYTES && 4 * STG_BYTES <= L_V + NSLOT * SLOT, "attention LDS");
__device__ __forceinline__ void glds16(const void* gsrc, unsigned lds_dst) { unsigned keep;
    asm volatile("s_mov_b32 %0, m0\n\ts_mov_b32 m0, %2\n\ts_nop 0\n\tglobal_load_lds_dwordx4 %1, off\n\ts_mov_b32 m0, %0" : "=&s"(keep) : "v"(gsrc), "s"(lds_dst) : "memory"); }
__device__ __forceinline__ unsigned cvtpk_s(float lo, float hi) { return pg8::cvt_pk_bf16(lo, hi); }
__device__ __forceinline__ int pslot_next(int slot) { return slot == 0 ? 2 : slot - 1; }
__device__ __forceinline__ void attn_unit(int b, int h, int qb, const bf16* Q, const bf16* K, const bf16* V, bf16* MIX, LAS unsigned char* lds, const LAS float* BLh, float lam, LAS float* als) {
    const int tid = threadIdx.x, lane = tid & 63, r32 = lane & 31, hi = lane >> 5; const int wid = __builtin_amdgcn_readfirstlane(tid >> 6), map = wid >> 2, qw = wid & 3;
    const long rowbase = (long)b * TP; const int q0 = qb * 128;
    const bf16* Qw = Q + (rowbase + q0 + qw * 32) * 512 + h * 128 + map * 64;
    const bf16* Kh = K + rowbase * 512 + h * 128; const bf16* Vh = V + rowbase * 512 + h * 128;
    const unsigned lds0 = (unsigned)(uintptr_t)lds;
    const bf16* ksrc0 = Kh + (long)lane * 512 + (wid >> 3) * 64 + (wid & 7) * 8;
    const bf16* ksrc1 = Kh + (long)lane * 512 + 64 + (wid & 7) * 8;
    const bf16* vsrc0 = Vh + (long)(16 * (wid & 3) + (lane >> 2)) * 512 + (wid >> 2) * 32 + (lane & 3) * 8;
    const bf16* vsrc1 = Vh + (long)(16 * (wid & 3) + (lane >> 2)) * 512 + (2 + (wid >> 2)) * 32 + (lane & 3) * 8;
#define ADMA(t, slot) do { const long o_ = (long)(t) * 64 * 512; const unsigned s_ = (unsigned)(slot) * SLOT; \
        glds16(ksrc0 + o_, (unsigned)__builtin_amdgcn_readfirstlane(lds0 + L_K + s_ + wid * 1024)); glds16(ksrc1 + o_, (unsigned)__builtin_amdgcn_readfirstlane(lds0 + L_K + s_ + (wid + 8) * 1024)); \
        glds16(vsrc0 + o_, (unsigned)__builtin_amdgcn_readfirstlane(lds0 + L_V + s_ + wid * 1024)); glds16(vsrc1 + o_, (unsigned)__builtin_amdgcn_readfirstlane(lds0 + L_V + s_ + (wid + 8) * 1024)); } while (0)
    const int NT = 2 * qb + 2;
    bf16x8 qr[4];
#pragma unroll
    for (int d0 = 0; d0 < 4; ++d0) qr[d0] = *(const bf16x8*)(Qw + (long)r32 * 512 + d0 * 16 + hi * 8);
    asm volatile("s_waitcnt vmcnt(0)" ::: "memory");
    ADMA(0, 0); ADMA(1, 1);
    f32x16 o[4];
#pragma unroll
    for (int d = 0; d < 4; ++d)
#pragma unroll
        for (int r = 0; r < 16; ++r) o[d][r] = 0.f;
    float lsum = 0.f;
    const float cfar = BLh[127];
    const int qabs = q0 + qw * 32 + r32;
    asm volatile("s_waitcnt vmcnt(4) lgkmcnt(0)\n\ts_barrier" ::: "memory");
    bf16x8 pa[4];
    int slot = 0, pslot = 0;
    for (int t = 0; t <= NT; ++t) {
        f32x16 p0, p1;
        if (t < NT) {
            const LAS unsigned char* kb = lds + L_K + slot * SLOT + map * 8192 + hi * 1024 + r32 * 16;
            const bool band = t >= NT - 4; const float ci = band ? 0.f : cfar;
#pragma unroll
            for (int r = 0; r < 16; ++r) { p0[r] = ci; p1[r] = ci; }
#pragma unroll
            for (int d0 = 0; d0 < 4; ++d0) { const bf16x8 b0 = *(const LAS bf16x8*)(kb + d0 * 2048), b1 = *(const LAS bf16x8*)(kb + d0 * 2048 + 512); p0 = MFMA32(b0, qr[d0], p0); p1 = MFMA32(b1, qr[d0], p1); }
            if (band) {
                const int nb = qabs - 64 * t - 4 * hi;
                float bv0[16], bv1[16];
#pragma unroll
                for (int r = 0; r < 16; ++r) { const int n0 = nb - ((r & 3) + 8 * (r >> 2)), n1 = n0 - 32; bv0[r] = BLh[n0 > 127 ? 127 : (n0 < 0 ? 0 : n0)]; bv1[r] = BLh[n1 > 127 ? 127 : (n1 < 0 ? 0 : n1)]; }
                asm volatile("s_waitcnt lgkmcnt(0)" ::: "memory");
#pragma unroll
                for (int r = 0; r < 16; ++r) { const int n0 = nb - ((r & 3) + 8 * (r >> 2)), n1 = n0 - 32; p0[r] = n0 < 0 ? -INFINITY : p0[r] + bv0[r]; p1[r] = n1 < 0 ? -INFINITY : p1[r] + bv1[r]; }
            }
        }
        const int vb = (int)(lds0 + L_V + pslot * SLOT) + ((lane >> 4) & 1) * 32 + (lane & 3) * 8 + (4 * hi + ((lane & 15) >> 2)) * 64;
#pragma unroll
        for (int d0 = 0; d0 < 4; ++d0) {
            if (t > 0) { s16x4 lo[4], hh[4];
#pragma unroll
                for (int ks = 0; ks < 4; ++ks) {
                    asm volatile("ds_read_b64_tr_b16 %0,%1 offset:%c2" : "=&v"(lo[ks]) : "v"(vb), "i"(d0 * 4096 + ks * 1024) : "memory");
                    asm volatile("ds_read_b64_tr_b16 %0,%1 offset:%c2" : "=&v"(hh[ks]) : "v"(vb), "i"(d0 * 4096 + ks * 1024 + 512) : "memory"); }
                asm volatile("s_waitcnt lgkmcnt(0)" : "+v"(lo[0]), "+v"(lo[1]), "+v"(lo[2]), "+v"(lo[3]), "+v"(hh[0]), "+v"(hh[1]), "+v"(hh[2]), "+v"(hh[3]) :: "memory");
#pragma unroll
                for (int ks = 0; ks < 4; ++ks) { const bf16x8 vf = (bf16x8){lo[ks][0], lo[ks][1], lo[ks][2], lo[ks][3], hh[ks][0], hh[ks][1], hh[ks][2], hh[ks][3]}; o[d0] = MFMA32(pa[ks], vf, o[d0]); }
            }
            if (t < NT) {
#pragma unroll
                for (int r = 4 * d0; r < 4 * d0 + 4; ++r) { p0[r] = ex2(p0[r]); p1[r] = ex2(p1[r]); }
            }
        }
        if (t < NT) {
            float sacc = 0.f;
#pragma unroll
            for (int r = 0; r < 16; ++r) sacc += p0[r] + p1[r];
            lsum += sacc;
            v4u w;
            w = (v4u){cvtpk_s(p0[0], p0[1]), cvtpk_s(p0[2], p0[3]), cvtpk_s(p0[4], p0[5]), cvtpk_s(p0[6], p0[7])}; pa[0] = __builtin_bit_cast(bf16x8, w);
            w = (v4u){cvtpk_s(p0[8], p0[9]), cvtpk_s(p0[10], p0[11]), cvtpk_s(p0[12], p0[13]), cvtpk_s(p0[14], p0[15])}; pa[1] = __builtin_bit_cast(bf16x8, w);
            w = (v4u){cvtpk_s(p1[0], p1[1]), cvtpk_s(p1[2], p1[3]), cvtpk_s(p1[4], p1[5]), cvtpk_s(p1[6], p1[7])}; pa[2] = __builtin_bit_cast(bf16x8, w);
            w = (v4u){cvtpk_s(p1[8], p1[9]), cvtpk_s(p1[10], p1[11]), cvtpk_s(p1[12], p1[13]), cvtpk_s(p1[14], p1[15])}; pa[3] = __builtin_bit_cast(bf16x8, w);
        }
        asm volatile("s_waitcnt vmcnt(0) lgkmcnt(0)\n\ts_barrier" ::: "memory");
        if (t + 2 < NT) { ADMA(t + 2, pslot_next(slot)); }
        pslot = slot; slot = slot == 2 ? 0 : slot + 1;
    }
#undef ADMA
    { auto rr = __builtin_amdgcn_permlane32_swap(__float_as_uint(lsum), __float_as_uint(lsum), false, false); lsum = __uint_as_float(rr[0]) + __uint_as_float(rr[1]); }
    LAS float* myl = als + wid * 32;
    if (hi == 0) myl[r32] = lsum;
    asm volatile("s_waitcnt vmcnt(0) lgkmcnt(0)\n\ts_barrier" ::: "memory");
    float rl[16];
#pragma unroll
    for (int r = 0; r < 16; ++r) rl[r] = __builtin_amdgcn_rcpf(myl[crow(r, hi)]);
    LAS float* stg = (LAS float*)(lds + L_STG + qw * STG_BYTES);
    if (map == 1) {
#pragma unroll
        for (int d = 0; d < 4; ++d)
#pragma unroll
            for (int r = 0; r < 16; ++r) stg[(d * 16 + r) * 64 + lane] = o[d][r] * rl[r];
    }
    asm volatile("s_waitcnt lgkmcnt(0)\n\ts_barrier" ::: "memory");
    if (map == 0) {
#pragma unroll
        for (int d = 0; d < 4; ++d)
#pragma unroll
            for (int r = 0; r < 16; ++r) o[d][r] = o[d][r] * rl[r] - lam * stg[(d * 16 + r) * 64 + lane];
        asm volatile("s_waitcnt lgkmcnt(0)" ::: "memory");
#pragma unroll
        for (int d = 0; d < 4; ++d)
#pragma unroll
            for (int r = 0; r < 16; ++r) stg[crow(r, hi) * 132 + d * 32 + r32] = o[d][r];
        asm volatile("s_waitcnt lgkmcnt(0)" ::: "memory");
        bf16* Mw = MIX + (rowbase + q0 + qw * 32) * 1024 + h * 128;
#pragma unroll
        for (int ps = 0; ps < 8; ++ps) { const int row = ps * 4 + (lane >> 4), seg = lane & 15;
            const f32x4 a = *(const LAS f32x4*)(stg + row * 132 + 8 * seg), c = *(const LAS f32x4*)(stg + row * 132 + 8 * seg + 4);
            float ss = (a[0] * a[0] + a[1] * a[1]) + (a[2] * a[2] + a[3] * a[3]) + (c[0] * c[0] + c[1] * c[1]) + (c[2] * c[2] + c[3] * c[3]);
            ss += __shfl_xor(ss, 1); ss += __shfl_xor(ss, 2); ss += __shfl_xor(ss, 4); ss += __shfl_xor(ss, 8);
            const float rstd = rsqrtf(ss * (1.0f / 128.0f) + EPSF);
            *(v4u*)(Mw + (long)row * 1024 + 8 * seg) = (v4u){cvtpk_s(a[0] * rstd, a[1] * rstd), cvtpk_s(a[2] * rstd, a[3] * rstd), cvtpk_s(c[0] * rstd, c[1] * rstd), cvtpk_s(c[2] * rstd, c[3] * rstd)}; }
    }
    asm volatile("s_waitcnt lgkmcnt(0)\n\ts_barrier" ::: "memory");
}
}
namespace dec {
typedef float f32x4 __attribute__((ext_vector_type(4)));
#define MFMA16(a, b, c) __builtin_amdgcn_mfma_f32_16x16x32_bf16((a), (b), (c), 0, 0, 0)
__device__ __forceinline__ bf16x8 cvt8(f32x4 a, f32x4 b) { v4u w = {pk2(a[0], a[1]), pk2(a[2], a[3]), pk2(b[0], b[1]), pk2(b[2], b[3])}; return __builtin_bit_cast(bf16x8, w); }
__device__ __forceinline__ void decode_unit(int item, const float* ck, const float* cv, const int* pt, const bf16* QB, const float* ksamp, const float* vsamp, bf16* MIX_unused_, LAS unsigned char* lds, const LAS float* BL, float lam, float* PART, gu32* dcnt, bf16* MIX) {
    const int b = item >> 2, qtr = item & 3;
    const int tid = threadIdx.x, lane = tid & 63, n = lane & 15, q = lane >> 4; const int wid = __builtin_amdgcn_readfirstlane(tid >> 6), h = wid & 3, kh = wid >> 2;
    const LAS float* BLh = BL + h * 128;
    LAS bf16x8* qfl = (LAS bf16x8*)(lds + 40960 + wid * 4096) + lane;
#pragma unroll
    for (int mp = 0; mp < 2; ++mp)
#pragma unroll
        for (int ks = 0; ks < 2; ++ks) { const int tk = n - 4 * mp; const bool ok = tk >= 0 && tk < 4;
            const v4u w = ok ? *(const v4u*)(QB + (size_t)(MP + 4 * b + tk) * 512 + h * 128 + mp * 64 + 32 * ks + 8 * q) : (v4u){0u, 0u, 0u, 0u}; qfl[(mp * 2 + ks) * 64] = __builtin_bit_cast(bf16x8, w); }
    asm volatile("s_waitcnt lgkmcnt(0)" ::: "memory");
    const int tok = n & 3;
    f32x4 O[8];
#pragma unroll
    for (int c = 0; c < 8; ++c) O[c] = (f32x4){0.f, 0.f, 0.f, 0.f};
    float lsum = 0.f;
    const int NIT = (kh == 0 && qtr == 3) ? 9 : 8;
    f32x4 kr[2][2][2][2], vr[8][2];
    const int vkey0 = 4 * q;
#define DEC_BASES(i_, KB_, VB_, K0_, NEW_) do { const bool nw_ = (i_) == 8; const int T_ = 16 * qtr + 2 * (i_) + kh; \
        if (!nw_) { const int phys_ = __builtin_amdgcn_readlane(ptv, T_ >> 2); const size_t ro_ = ((size_t)phys_ * PAGE + 32 * (T_ & 3)) * 512 + h * 128; KB_ = ck + ro_; VB_ = cv + ro_; K0_ = 32 * T_; } \
        else { const size_t ro_ = (size_t)(4 * b) * 512 + h * 128; KB_ = ksamp + ro_; VB_ = vsamp + ro_; K0_ = PAST; } NEW_ = nw_; } while (0)
#define DEC_LOADK(KB_, NEW_) do { _Pragma("unroll") for (int sub = 0; sub < 2; ++sub) { int key_ = 16 * sub + n; if (NEW_) key_ = key_ > 3 ? 3 : key_; const float* kp_ = (KB_) + (size_t)key_ * 512 + 8 * q; \
        _Pragma("unroll") for (int mp = 0; mp < 2; ++mp) _Pragma("unroll") for (int ks = 0; ks < 2; ++ks) { kr[sub][mp][ks][0] = *(const f32x4*)(kp_ + mp * 64 + 32 * ks); kr[sub][mp][ks][1] = *(const f32x4*)(kp_ + mp * 64 + 32 * ks + 4); } } } while (0)
#define DEC_LOADV(VB_, NEW_) do { _Pragma("unroll") for (int j = 0; j < 8; ++j) { int key_ = (j < 4) ? vkey0 + j : 16 + vkey0 + (j - 4); if (NEW_) key_ = key_ > 3 ? 3 : key_; \
        _Pragma("unroll") for (int hf = 0; hf < 2; ++hf) vr[j][hf] = *(const f32x4*)((VB_) + (size_t)key_ * 512 + 64 * hf + 4 * n); } } while (0)
    const int ptv = pt[b * NPAGES + (lane & 15)];
    const float* kbase; const float* vbase; int key0; bool isnew;
    DEC_BASES(0, kbase, vbase, key0, isnew);
    DEC_LOADK(kbase, isnew);
    for (int i = 0; i < NIT; ++i) {
        __builtin_amdgcn_sched_barrier(0);
        DEC_LOADV(vbase, isnew);
        __builtin_amdgcn_sched_barrier(0);
        f32x4 s[2];
#pragma unroll
        for (int sub = 0; sub < 2; ++sub) {
            s[sub] = (f32x4){0.f, 0.f, 0.f, 0.f};
#pragma unroll
            for (int mp = 0; mp < 2; ++mp)
#pragma unroll
                for (int ks = 0; ks < 2; ++ks) s[sub] = MFMA16(cvt8(kr[sub][mp][ks][0], kr[sub][mp][ks][1]), qfl[(mp * 2 + ks) * 64], s[sub]);
        }
        const int key0c = key0; const bool isnewc = isnew;
        __builtin_amdgcn_sched_barrier(0);
        const float* vb_cur = vbase;
        if (i + 1 < NIT) { DEC_BASES(i + 1, kbase, vbase, key0, isnew); DEC_LOADK(kbase, isnew); }
        __builtin_amdgcn_sched_barrier(0);
        (void)vb_cur;
        f32x4 p[2], bvs[2];
#pragma unroll
        for (int sub = 0; sub < 2; ++sub)
#pragma unroll
            for (int r = 0; r < 4; ++r) { const int dist = PAST + tok - (key0c + 16 * sub + 4 * q + r); bvs[sub][r] = BLh[dist > 127 ? 127 : (dist < 0 ? 0 : dist)]; }
        asm volatile("s_waitcnt lgkmcnt(0)" ::: "memory");
#pragma unroll
        for (int sub = 0; sub < 2; ++sub)
#pragma unroll
            for (int r = 0; r < 4; ++r) { const int kl = 16 * sub + 4 * q + r; const int dist = PAST + tok - (key0c + kl);
                bool ok = n < 8; if (isnewc) ok = ok && kl < 4 && dist >= 0;
                const float e = ex2(s[sub][r] + bvs[sub][r]); p[sub][r] = ok ? e : 0.f; }
        lsum += ((p[0][0] + p[0][1]) + (p[0][2] + p[0][3])) + ((p[1][0] + p[1][1]) + (p[1][2] + p[1][3]));
        const bf16x8 pf = cvt8(p[0], p[1]);
#pragma unroll
        for (int hf = 0; hf < 2; ++hf)
#pragma unroll
            for (int c = 0; c < 4; ++c) { const v4u w = {pk2(vr[0][hf][c], vr[1][hf][c]), pk2(vr[2][hf][c], vr[3][hf][c]), pk2(vr[4][hf][c], vr[5][hf][c]), pk2(vr[6][hf][c], vr[7][hf][c])};
                O[hf * 4 + c] = MFMA16(pf, __builtin_bit_cast(bf16x8, w), O[hf * 4 + c]); }
    }
#undef DEC_BASES
#undef DEC_LOADK
#undef DEC_LOADV
    lsum += __shfl_xor(lsum, 16); lsum += __shfl_xor(lsum, 32);
    LAS float* cb = (LAS float*)lds + h * (33 * 64);
    if (kh == 1) {
#pragma unroll
        for (int c = 0; c < 8; ++c)
#pragma unroll
            for (int r = 0; r < 4; ++r) cb[(c * 4 + r) * 64 + lane] = O[c][r];
        cb[32 * 64 + lane] = lsum;
    }
    LDS_SYNC();
    float* const pp = PART + ((size_t)(item * 4 + h)) * 1056;
    if (kh == 0) {
#pragma unroll
        for (int c = 0; c < 8; ++c)
#pragma unroll
            for (int r = 0; r < 4; ++r) O[c][r] += cb[(c * 4 + r) * 64 + lane];
        lsum += cb[32 * 64 + lane];
        if (lane < 32) {
#pragma unroll
            for (int c = 0; c < 8; ++c)
#pragma unroll
                for (int r = 0; r < 4; ++r) __hip_atomic_store(pp + (c * 4 + r) * 32 + lane, O[c][r], RLX_AGENT);
            if (q == 0) __hip_atomic_store(pp + 1024 + n, lsum, RLX_AGENT);
        }
    }
    asm volatile("s_waitcnt vmcnt(0)" ::: "memory");
    LAS unsigned* tick = (LAS unsigned*)lds + 4 * 33 * 64 + 64;
    LDS_SYNC();
    if (tid == 0) tick[0] = __hip_atomic_fetch_add(dcnt + b, 1u, RLX_AGENT);
    LDS_SYNC();
    const bool last = __builtin_amdgcn_readfirstlane((int)tick[0]) == 3;
    if (last && kh == 0) {
#pragma unroll
        for (int c = 0; c < 8; ++c) O[c] = (f32x4){0.f, 0.f, 0.f, 0.f};
        lsum = 0.f;
#pragma unroll
        for (int qq = 0; qq < 4; ++qq) { const float* ps = PART + ((size_t)((b * 4 + qq) * 4 + h)) * 1056;
            if (lane < 32) {
#pragma unroll
                for (int c = 0; c < 8; ++c)
#pragma unroll
                    for (int r = 0; r < 4; ++r) O[c][r] += __hip_atomic_load(ps + (c * 4 + r) * 32 + lane, RLX_AGENT);
            }
            lsum += __hip_atomic_load(ps + 1024 + n, RLX_AGENT); }
        LAS float* ls = (LAS float*)lds + 4 * 33 * 64 + h * 16;
        if (q == 0) ls[n] = lsum;
        asm volatile("s_waitcnt lgkmcnt(0)" ::: "memory");
        float y[8][4], ss[4] = {0.f, 0.f, 0.f, 0.f};
#pragma unroll
        for (int r = 0; r < 4; ++r) { const float rl0 = __builtin_amdgcn_rcpf(ls[r]), rl1 = __builtin_amdgcn_rcpf(ls[4 + r]);
#pragma unroll
            for (int c = 0; c < 8; ++c) { const float o1 = __shfl(O[c][r], (lane & 15) + 16); y[c][r] = O[c][r] * rl0 - lam * o1 * rl1; ss[r] += y[c][r] * y[c][r]; } }
#pragma unroll
        for (int r = 0; r < 4; ++r) { ss[r] += __shfl_xor(ss[r], 1); ss[r] += __shfl_xor(ss[r], 2); ss[r] += __shfl_xor(ss[r], 4); ss[r] += __shfl_xor(ss[r], 8); }
        if (q == 0) {
#pragma unroll
            for (int r = 0; r < 4; ++r) { const float rstd = rsqrtf(ss[r] * (1.0f / 128.0f) + EPSF); bf16* mo = MIX + (size_t)(MP + 4 * b + r) * 1024 + h * 128 + 4 * n;
#pragma unroll
                for (int hf = 0; hf < 2; ++hf) *(v2u*)(mo + 64 * hf) = (v2u){pk2(y[hf * 4][r] * rstd, y[hf * 4 + 1][r] * rstd), pk2(y[hf * 4 + 2][r] * rstd, y[hf * 4 + 3][r] * rstd)}; }
        }
    }
    LDS_SYNC();
}
}
#ifndef NDEC_CU
#define NDEC_CU 88
#endif
#ifndef REP_P0
#define REP_P0 1
#endif
#ifndef REP_H1
#define REP_H1 1
#endif
#ifndef REP_H3
#define REP_H3 1
#endif
#ifndef REP_P5
#define REP_P5 1
#endif
#ifndef REP_SH
#define REP_SH 1
#endif
#ifndef REP_SCAN
#define REP_SCAN 1
#endif
#ifndef REP_FIX
#define REP_FIX 1
#endif
#ifndef REP_P7
#define REP_P7 1
#endif
#ifndef REP_Q
#define REP_Q 1
#endif
#ifndef REP_DEC
#define REP_DEC 1
#endif
#ifndef REP_ATT
#define REP_ATT 1
#endif
#ifndef REP_P1
#define REP_P1 1
#endif
#ifndef REP_P6
#define REP_P6 1
#endif
struct Args { PIn in; float* out; unsigned char* ws; };
typedef __attribute__((address_space(4))) const Args* KArgs;
__device__ __forceinline__ void p0_prologue(KArgs A, unsigned char* ws, LAS unsigned char* lds, int vcu, int G, int wave, int lane) {
    LAS float* scr = (LAS float*)(lds + RING_OFF + wave * 16384);
    const int gw = vcu * NWAVES + wave, NGW = G * NWAVES;
    bf16* WIN = (bf16*)(ws + WS_WIN); bf16* WOUT = (bf16*)(ws + WS_WOUT); bf16* WGU = (bf16*)(ws + WS_WGU); bf16* WDN = (bf16*)(ws + WS_WDN);
    constexpr int I_IN = 16 * 112, I_OUT = 16 * 32, I_G = 16 * 88, I_D = 44 * 32, NITEMS = I_IN + I_OUT + 2 * I_G + I_D;
    for (int it = gw; it < NITEMS; it += NGW) {
        int r = it;
        if (r < I_IN) { const int kb = r / 112, nb = r % 112, pn = nb >> 3, cbk = nb & 7; const float* g1 = A->in.g1;
            p0_transpose_item(A->in.win, DM, NIN, WIN, kb, nb, 256 * pn + 128 * (cbk & 1) + 32 * (cbk >> 1), scr, lane, [g1](int k) { return g1[k]; }); continue; } r -= I_IN;
        if (r < I_OUT) { const int kb = r / 32, nb = r % 32; const float* sg = A->in.subg; const float* og = A->in.ong;
            p0_transpose_item(A->in.wout, DM, DM, WOUT, kb, nb, 32 * nb, scr, lane, [sg, og](int k) { return k < 512 ? 0.8f * sg[k & 127] : og[k & 127]; }); continue; } r -= I_OUT;
        if (r < I_G) { const int kb = r / 88, nb = r % 88; const float* g2 = A->in.g2;
            p0_transpose_item(A->in.wg, DM, DFF, WGU, kb, nb, 256 * (nb >> 2) + 32 * (nb & 3), scr, lane, [g2](int k) { return g2[k]; }); continue; } r -= I_G;
        if (r < I_G) { const int kb = r / 88, nb = r % 88; const float* g2 = A->in.g2;
            p0_transpose_item(A->in.wu, DM, DFF, WGU, kb, nb, 256 * (nb >> 2) + 128 + 32 * (nb & 3), scr, lane, [g2](int k) { return g2[k]; }); continue; } r -= I_G;
        { const int kb = r / 32, nb = r % 32; p0_transpose_item(A->in.wd, DFF, DM, WDN, kb, nb, 32 * nb, scr, lane, [](int) { return 1.0f; }); }
    }
    bf16* XB = (bf16*)(ws + WS_XB); float* RSTD1 = (float*)(ws + WS_RSTD1);
    for (int m = gw; m < MALL; m += NGW) {
        const float* xrow = m < MP ? A->in.xp + (size_t)m * DM : A->in.xs + (size_t)(m - MP) * DM;
        const GAS f32x4* xr = (const GAS f32x4*)xrow + lane; f32x4 v[4]; float s = 0.f;
#pragma unroll
        for (int j = 0; j < 4; ++j) { v[j] = xr[64 * j]; s += (v[j][0] * v[j][0] + v[j][1] * v[j][1]) + (v[j][2] * v[j][2] + v[j][3] * v[j][3]); }
        s = wave_sum(s);
        GAS v2u* o8 = (GAS v2u*)(XB + (size_t)m * DM) + lane;
#pragma unroll
        for (int j = 0; j < 4; ++j) o8[64 * j] = (v2u){pk2(v[j][0], v[j][1]), pk2(v[j][2], v[j][3])};
        if (lane == 0) RSTD1[m] = rsqrtf(s * (1.0f / DM) + EPSF);
    }
}
__device__ __forceinline__ void conv_fixup(int pm, const float* cwp, const float* cbp, unsigned char* ws, int tid) {
    const float* HA = (const float*)(ws + WS_HALOA); const float* HU = (const float*)(ws + WS_HALOU); const float* LA = (const float*)(ws + WS_LASTA); bf16* G = (bf16*)(ws + WS_G);
    const bool first = (pm & 31) == 0;
    for (int e = tid; e < 2 * DFF; e += NWAVES * 64) {
        const int i = e >= DFF, c = e - i * DFF;
        const float a = HA[(size_t)(pm * 2 + i) * DFF + c], u = HU[(size_t)(pm * 2 + i) * DFF + c];
        float p1, p2;
        if (i == 0) { p1 = first ? 0.f : LA[(size_t)((pm - 1) * 2 + 1) * DFF + c]; p2 = first ? 0.f : LA[(size_t)((pm - 1) * 2) * DFF + c]; }
        else { p1 = HA[(size_t)(pm * 2) * DFF + c]; p2 = first ? 0.f : LA[(size_t)((pm - 1) * 2 + 1) * DFF + c]; }
        const float cc = cbp[c] + cwp[c] * p2 + cwp[DFF + c] * p1 + cwp[2 * DFF + c] * a;
        G[(size_t)(pm * 256 + i) * DFF + c] = (bf16)f2bf(cc * sigm_f(cc) * u);
    }
}
__device__ __forceinline__ KArgs kargs() { KArgs p = (KArgs)__builtin_amdgcn_kernarg_segment_ptr(); asm volatile("" : "+s"(p)); return p; }
__global__ void __launch_bounds__(NWAVES * 64, 2) fwd(Args args_unused) {
    extern __shared__ __attribute__((aligned(16))) unsigned char lds_raw[];
    LAS unsigned char* lds = (LAS unsigned char*)lds_raw;
    const int tid = threadIdx.x, lane = tid & 63, wave = __builtin_amdgcn_readfirstlane(tid >> 6);
    const int G = gridDim.x, bx = blockIdx.x, vcu = (G % 8 == 0) ? (bx % 8) * (G / 8) + bx / 8 : bx;
    for (int u = tid; u < (LDS_BYTES - LDSCTL_OFF) / 4; u += NWAVES * 64) ((LAS unsigned*)(lds + LDSCTL_OFF))[u] = 0u;
    __syncthreads();
    volatile LAS unsigned* MISC = (volatile LAS unsigned*)(lds + MISC_OFF);
    XcdBarrier bar;
    { KArgs A = kargs(); bar = xcd_barrier_post((unsigned*)(A->ws + WS_CTL) + CW_BAR, MISC + 8); }
    LAS float* BL = (LAS float*)(lds + BL_OFF); LAS float* SCAL = (LAS float*)(lds + SCAL_OFF);
    { KArgs A = kargs(); const float* relb = A->in.relb; const float* lqk = A->in.lqk;
      const int h = tid >> 7, n = tid & 127; int bk = n;
      if (n >= 16) { bk = 16 + (int)(logf((float)n * (1.0f / 16.0f)) / logf(8.0f) * 16.0f); bk = bk > 31 ? 31 : bk; }
      BL[h * 128 + n] = relb[bk * 4 + h] * LOG2E_F;
      if (tid < 64) { float a = lqk[tid] * lqk[64 + tid], c = lqk[128 + tid] * lqk[192 + tid]; a = wave_sum(a); c = wave_sum(c); if (tid == 0) SCAL[0] = expf(a) - expf(c) + 0.2f; } }
    __syncthreads();

#ifdef DIAG_TS
#define TSTAMP(i) do { if (bx == 0 && tid == 0) ((volatile LAS unsigned*)(lds + MISC_OFF))[16 + (i)] = (unsigned)__builtin_amdgcn_s_memrealtime(); } while (0)
#else
#define TSTAMP(i) do {} while (0)
#endif
    TSTAMP(0);
    for (int rep_ = 0; rep_ < REP_P0; ++rep_) { KArgs A = kargs(); p0_prologue(A, A->ws, lds, vcu, G, wave, lane); }
    xcd_barrier(bar);
    TSTAMP(1);
    { KArgs A = kargs(); unsigned char* ws = A->ws; float* out = A->out;
      pg8::Gemm g{(const bf16*)(ws + WS_XB), (const bf16*)(ws + WS_WIN), MALL, NIN, DM, DM}; pg8::StaticOrder S; S.init(MALL, NIN, G, bx);
      pg8::EpiIn E{(bf16*)(ws + WS_QB), (float*)(ws + WS_HLF), out + O_KP, out + O_KS, (const float*)(ws + WS_RSTD1), A->in.gqk, A->in.hlb};
      for (int rep_ = 0; rep_ < REP_P1; ++rep_) pg8::gemm_phase<pg8::EpiIn, pg8::StaticOrder, PG8_ALIGN, PG8_SP2>(lds + RING_OFF, g, S, E); }
    xcd_barrier(bar);
    TSTAMP(2);
    { KArgs A = kargs(); unsigned char* ws = A->ws;
      for (int rep_ = 0; rep_ < REP_H1; ++rep_) for (int u = vcu; u < 256; u += G) hgrn_unit<false>(u, lds, (const float*)(ws + WS_HLF), (const bf16*)(ws + WS_HQ), (const bf16*)(ws + WS_HV), (const bf16*)(ws + WS_HG), (bf16*)(ws + WS_MIX), (float*)(ws + WS_UBUF), (float*)(ws + WS_DTOT), (const float*)(ws + WS_SST)); }
    xcd_barrier(bar);
    TSTAMP(3);
    { KArgs A = kargs(); unsigned char* ws = A->ws;
      for (int rep_ = 0; rep_ < REP_SCAN; ++rep_) hgrn_scan(vcu * (NWAVES * 64) + tid, G * NWAVES * 64, (const float*)(ws + WS_UBUF), (const float*)(ws + WS_DTOT), (float*)(ws + WS_SST), A->out + O_HP); }
    xcd_barrier(bar);
    TSTAMP(4);
    { KArgs A = kargs(); unsigned char* ws = A->ws;
      for (int rep_ = 0; rep_ < REP_H3; ++rep_) for (int u = vcu; u < 256; u += G) hgrn_unit<true>(u, lds, (const float*)(ws + WS_HLF), (const bf16*)(ws + WS_HQ), (const bf16*)(ws + WS_HV), (const bf16*)(ws + WS_HG), (bf16*)(ws + WS_MIX), (float*)(ws + WS_UBUF), (float*)(ws + WS_DTOT), (const float*)(ws + WS_SST)); }
#ifdef DIAG_T9
    { KArgs A = kargs(); unsigned char* ws = A->ws;
      for (int u = vcu; u < 8; u += G) hgrn_seq_unit(u, lds, (const float*)(ws + WS_HLF), (const bf16*)(ws + WS_HQ), (const bf16*)(ws + WS_HV), (const bf16*)(ws + WS_HG), (bf16*)(ws + WS_MIX)); }
#endif
    { KArgs A = kargs(); unsigned char* ws = A->ws;
      for (int rep_ = 0; rep_ < REP_SH; ++rep_) for (int u = vcu; u < NBS * 4; u += G) hgrn_sample_unit(u, lds, A->in.sh, (const float*)(ws + WS_HLF), (const bf16*)(ws + WS_HQ), (const bf16*)(ws + WS_HV), (const bf16*)(ws + WS_HG), (bf16*)(ws + WS_MIX), A->out + O_HS); }
    TSTAMP(8);
    { KArgs A = kargs(); unsigned char* ws = A->ws; const float lam = SCAL[0];
      const bf16* QB = (const bf16*)(ws + WS_QB); const bf16* KB = (const bf16*)(ws + WS_KB); const bf16* VB = (const bf16*)(ws + WS_VB); bf16* MIX = (bf16*)(ws + WS_MIX);
      gu32* qd = (gu32*)(ws + WS_CTL) + CW_QDEC; gu32* qa = (gu32*)(ws + WS_CTL) + CW_QATT;
      volatile LAS unsigned* qs = (volatile LAS unsigned*)(lds + MISC_OFF) + 12;
      int mode = (bx >> 3) < (NDEC_CU / 8) ? 0 : 1, done = 0;
      for (;;) {
        if (tid == 0) qs[0] = __hip_atomic_fetch_add(mode == 0 ? qd : qa, 1u, RLX_AGENT);
        LDS_SYNC(); const int i = __builtin_amdgcn_readfirstlane((int)qs[0]); LDS_SYNC();
        if (i >= 512 * REP_Q) { if (++done == 2) break; mode ^= 1; continue; }
        if (mode == 0) dec::decode_unit(i % 512, A->in.ck, A->in.cv, A->in.pt, QB, A->out + O_KS, A->out + O_VS, MIX, lds, BL, lam, (float*)(ws + WS_DPART), (gu32*)(ws + WS_CTL) + CW_DCNT, MIX);
        else { const int bh = i & 7, qb = 63 - ((i >> 3) & 63); att::attn_unit(bh >> 2, bh & 3, qb, QB, KB, VB, MIX, lds, BL + (bh & 3) * 128, lam, (LAS float*)(lds + ALS_OFF)); }
      } }
    TSTAMP(9);
    xcd_barrier(bar);
    TSTAMP(5);
    { KArgs A = kargs(); unsigned char* ws = A->ws; float* out = A->out;
      pg8::Gemm g{(const bf16*)(ws + WS_MIX), (const bf16*)(ws + WS_WOUT), MALL, DM, DM, DM}; pg8::StaticOrder S; S.init(MALL, DM, G, bx);
      pg8::EpiOut E{A->in.xp, A->in.xs, out + O_YP, out + O_YS, (bf16*)(ws + WS_X1B), (float*)(ws + WS_SSQP)};
      for (int rep_ = 0; rep_ < REP_P5; ++rep_) pg8::gemm_phase<pg8::EpiOut, pg8::StaticOrder, PG8_ALIGN, PG8_SP2>(lds + RING_OFF, g, S, E); }
    xcd_barrier(bar);
    TSTAMP(6);
    { KArgs A = kargs(); unsigned char* ws = A->ws; float* out = A->out;
      pg8::Gemm g{(const bf16*)(ws + WS_X1B), (const bf16*)(ws + WS_WGU), MALL, 2 * DFF, DM, DM}; pg8::StaticOrder S; S.init(MALL, 2 * DFF, G, bx);
      pg8::EpiGU E{(bf16*)(ws + WS_G), (const float*)(ws + WS_SSQP), A->in.cw, A->in.cb, A->in.sconv, (float*)(ws + WS_HALOA), (float*)(ws + WS_HALOU), (float*)(ws + WS_LASTA), out + O_CP, out + O_CS, (PG8_LAS float*)(lds + XCH_OFF)};
      for (int rep_ = 0; rep_ < REP_P6; ++rep_) pg8::gemm_phase<pg8::EpiGU, pg8::StaticOrder, true, PG8_SP2>(lds + RING_OFF, g, S, E); }
    xcd_barrier(bar);
    TSTAMP(7);
    { KArgs A = kargs(); unsigned char* ws = A->ws; float* out = A->out;
      pg8::Gemm g{(const bf16*)(ws + WS_G), (const bf16*)(ws + WS_WDN), MALL, DM, DFF, DFF};
      pg8::DownOrder S; S.S0.init(MP, DM, G, bx); S.c = bx; S.nsplit = 11; S.klen = 256;
      { const float* cwp = A->in.cw; const float* cbp = A->in.cb; pg8::Unit u; for (int rep_ = 0; rep_ < REP_FIX; ++rep_) if (S.S0.next(0, u)) conv_fixup(u.pm, cwp, cbp, ws, tid); }
      asm volatile("s_waitcnt vmcnt(0)" ::: "memory"); __syncthreads();
      pg8::EpiDown E{out + O_YP, out + O_YS, (float*)(ws + WS_PART)};
#if REP_P7 > 1
      { pg8::EpiNull EN; pg8::gemm_phase<pg8::EpiNull, pg8::DownOrder, PG8_ALIGN, PG8_SP2>(lds + RING_OFF, g, S, EN); }
#endif
      pg8::gemm_phase<pg8::EpiDown, pg8::DownOrder, PG8_ALIGN, PG8_SP2>(lds + RING_OFF, g, S, E);
    }
    xcd_barrier(bar);
    { KArgs A = kargs(); const float* part = (const float*)(A->ws + WS_PART); float* ys = A->out + O_YS;
      for (int e4 = (vcu * (NWAVES * 64) + tid); e4 < MS * DM / 4; e4 += G * NWAVES * 64) {
        f32x4 s = *(const f32x4*)(ys + (size_t)e4 * 4);
#pragma unroll
        for (int p = 0; p < 11; ++p) s += *(const f32x4*)(part + (size_t)p * MS * DM + (size_t)e4 * 4);
        *(f32x4*)(ys + (size_t)e4 * 4) = s; }
    }
}

extern "C" void kernel_launch(void* const* d_in, const int* in_sizes, int n_in, void* d_out, int out_size, void* d_ws, size_t ws_size, hipStream_t stream) {
    static int grid = 0;
    if (grid == 0) {
        if (n_in != 22 || out_size != (int)O_END || ws_size < WS_END) { fprintf(stderr, "kernel_launch: unexpected shapes: n_in %d out %d ws %zu\n", n_in, out_size, ws_size); grid = -1; return; }
        int dev = 0, cus = 0, per_cu = 0;
        if (hipGetDevice(&dev) != hipSuccess || hipDeviceGetAttribute(&cus, hipDeviceAttributeMultiprocessorCount, dev) != hipSuccess) { grid = -1; return; }
        if (hipFuncSetAttribute((const void*)fwd, hipFuncAttributeMaxDynamicSharedMemorySize, LDS_BYTES) != hipSuccess) { fprintf(stderr, "kernel_launch: hipFuncSetAttribute failed\n"); grid = -1; return; }
        if (hipOccupancyMaxActiveBlocksPerMultiprocessor(&per_cu, (const void*)fwd, NWAVES * 64, LDS_BYTES) != hipSuccess || per_cu < 1) fprintf(stderr, "kernel_launch: occupancy query says %d\n", per_cu);
        (void)hipGetLastError();
        grid = cus;
    }
    if (grid < 0) return;
    if (hipMemsetAsync((char*)d_ws + WS_CTL, 0, CTL_ZERO_BYTES, stream) != hipSuccess) return;
    Args a{};
    const void** pp = (const void**)&a.in;
    for (int i = 0; i < 22; ++i) pp[i] = d_in[i];
    a.out = (float*)d_out; a.ws = (unsigned char*)d_ws;
    hipLaunchKernelGGL(fwd, dim3(grid), dim3(NWAVES * 64), LDS_BYTES, stream, a);
}
```
